# Optimizing an MI355X kernel written in HIP

```python
import jax, jax.numpy as jnp
from jax import lax
import numpy as np

D_MODEL = 1024
BATCH = 16
SEQ = 2048
DEPTH = 1

HEAD_DIM = 64
NSA_HEADS = 8
NSA_KV_GROUPS = 2
FOX_HEADS = 8
ROT_DIM = HEAD_DIM // 4
ROPE_THETA = 500000.0
CMP_BLOCK = 32
CMP_STRIDE = 16
SEL_BLOCK = 64
N_SEL = 8
WINDOW = 512
Q_BLOCK = 128
N_EXPERTS = 32
TOP_K = 4
D_FF = D_MODEL
SWIGLU_ALPHA = 1.702
SWIGLU_LIMIT = 7.0
MOE_BLOCK = 128
NORM_EPS = 1e-6
NEG = -1e30
FORCE_BONUS = 1e4

NSA_Q = NSA_HEADS * HEAD_DIM
NSA_KV = NSA_KV_GROUPS * HEAD_DIM
NSA_GATE = NSA_HEADS * 3
FOX_W = FOX_HEADS * HEAD_DIM
IN_SIZES = [NSA_Q, NSA_KV, NSA_KV, NSA_KV, NSA_KV, NSA_KV, NSA_KV, NSA_GATE, FOX_W, FOX_W, FOX_W, FOX_HEADS, D_MODEL, D_MODEL]
IN_COLS = sum(IN_SIZES)
IN_SPLITS = [int(v) for v in np.cumsum(IN_SIZES)[:-1]]

kernel_name = 'hybrid_nsa_fox_moe_block'


def rms_norm(x, g):
    xf = x.astype(jnp.float32)
    y = xf * lax.rsqrt(jnp.mean(xf * xf, axis=-1, keepdims=True) + NORM_EPS)
    return (y * g.astype(jnp.float32)).astype(x.dtype)


def masked_softmax(logits, mask):
    l = jnp.where(mask, logits.astype(jnp.float32), NEG)
    return jnp.where(mask, jax.nn.softmax(l, axis=-1), 0.0)


def partial_rope(x, positions):
    freqs = ROPE_THETA ** (-jnp.arange(0, ROT_DIM, 2, dtype=jnp.float32) / ROT_DIM)
    ang = positions.astype(jnp.float32)[..., None] * freqs
    cos, sin = jnp.cos(ang)[:, :, None, :], jnp.sin(ang)[:, :, None, :]
    xr = x[..., :ROT_DIM].astype(jnp.float32)
    x1, x2 = xr[..., :ROT_DIM // 2], xr[..., ROT_DIM // 2:]
    rot = jnp.concatenate([x1 * cos - x2 * sin, x2 * cos + x1 * sin], axis=-1)
    return jnp.concatenate([rot.astype(x.dtype), x[..., ROT_DIM:]], axis=-1)


def compress_blocks(kv, pos_emb, w1, w2):
    B, S, G, DH = kv.shape
    n_c = (S - CMP_BLOCK) // CMP_STRIDE + 1
    idx = np.arange(n_c)[:, None] * CMP_STRIDE + np.arange(CMP_BLOCK)[None, :]
    blk = kv[:, idx] + pos_emb[None, None, :, None, :]
    blk = jnp.moveaxis(blk, 3, 2).reshape(B, n_c, G, CMP_BLOCK * DH)
    return jax.nn.gelu(blk @ w1) @ w2


def nsa_mixer(q, k_c, v_c, k_s, v_s, k_w, v_w, gate_logits, positions, cmp_pos_emb, cmp_w1, cmp_w2):
    B, S = q.shape[:2]
    G, HPG, DH = NSA_KV_GROUPS, NSA_HEADS // NSA_KV_GROUPS, HEAD_DIM
    scale = DH ** -0.5
    n_q = S // Q_BLOCK
    q = q.reshape(B, S, NSA_HEADS, DH)
    k_c, v_c, k_s, v_s, k_w, v_w = [a.reshape(B, S, G, DH) for a in (k_c, v_c, k_s, v_s, k_w, v_w)]
    t = jnp.arange(S)

    kcmp = compress_blocks(k_c, cmp_pos_emb[0], cmp_w1[0], cmp_w2[0])
    vcmp = compress_blocks(v_c, cmp_pos_emb[1], cmp_w1[1], cmp_w2[1])
    n_c = kcmp.shape[1]
    cmp_end = jnp.arange(n_c) * CMP_STRIDE + CMP_BLOCK - 1
    cmp_mask = cmp_end[None, :] <= t[:, None]
    qg = q.reshape(B, S, G, HPG, DH)
    logits = jnp.einsum('bsghd,bcgd->bghsc', qg, kcmp) * scale
    p_cmp = masked_softmax(logits, cmp_mask)
    o_c = jnp.einsum('bghsc,bcgd->bsghd', p_cmp.astype(vcmp.dtype), vcmp).reshape(B, S, NSA_HEADS, DH)

    n_sb = S // SEL_BLOCK
    n_sel = min(N_SEL, n_sb)
    ci = np.arange(n_c)[:, None] * CMP_STRIDE
    sj = np.arange(n_sb)[None, :] * SEL_BLOCK
    overlap = jnp.asarray(((ci < sj + SEL_BLOCK) & (ci + CMP_BLOCK > sj)).astype(np.float32))
    imp = jnp.einsum('bghsc,cj->bgsj', p_cmp, overlap)
    blk_id = jnp.arange(n_sb)[None, :]
    cur = (t // SEL_BLOCK)[:, None]
    valid = blk_id * SEL_BLOCK <= t[:, None]
    forced = (blk_id == 0) | (blk_id == cur) | (blk_id == cur - 1)
    score = jnp.where(forced, imp + FORCE_BONUS, jnp.where(valid, imp, NEG))
    _, sel_idx = lax.top_k(score, n_sel)

    q_r = partial_rope(q, positions).reshape(B, S, G, HPG, DH)
    k_s = partial_rope(k_s, positions)
    k_w = partial_rope(k_w, positions)
    q_blk = jnp.moveaxis(q_r.reshape(B, n_q, Q_BLOCK, G, HPG, DH), 1, 0)

    ks_blk = k_s.reshape(B, n_sb, SEL_BLOCK, G, DH).transpose(0, 3, 1, 2, 4)
    vs_blk = v_s.reshape(B, n_sb, SEL_BLOCK, G, DH).transpose(0, 3, 1, 2, 4)
    idx_blk = jnp.moveaxis(sel_idx.reshape(B, G, n_q, Q_BLOCK, n_sel), 2, 0)
    bi = jnp.arange(B)[:, None, None, None]
    gi = jnp.arange(G)[None, :, None, None]

    def sel_step(args):
        qb, ib, i = args
        tq = i * Q_BLOCK + jnp.arange(Q_BLOCK)
        kg = ks_blk[bi, gi, ib]
        vg = vs_blk[bi, gi, ib]
        lg = jnp.einsum('bqghd,bgqnkd->bgqhnk', qb, kg) * scale
        kpos = ib[..., None] * SEL_BLOCK + jnp.arange(SEL_BLOCK)
        mask = (kpos <= tq[:, None, None])[:, :, :, None].reshape(B, G, Q_BLOCK, 1, n_sel * SEL_BLOCK)
        p = masked_softmax(lg.reshape(B, G, Q_BLOCK, HPG, n_sel * SEL_BLOCK), mask)
        p = p.reshape(B, G, Q_BLOCK, HPG, n_sel, SEL_BLOCK).astype(vg.dtype)
        return jnp.einsum('bgqhnk,bgqnkd->bqghd', p, vg)

    o_s = lax.map(sel_step, (q_blk, idx_blk, jnp.arange(n_q)))
    o_s = jnp.moveaxis(o_s, 0, 1).reshape(B, S, NSA_HEADS, DH)

    kw_pad = jnp.pad(k_w, ((0, 0), (WINDOW, 0), (0, 0), (0, 0)))
    vw_pad = jnp.pad(v_w, ((0, 0), (WINDOW, 0), (0, 0), (0, 0)))

    def win_step(args):
        qb, i = args
        start = i * Q_BLOCK
        kb = lax.dynamic_slice_in_dim(kw_pad, start, WINDOW + Q_BLOCK, axis=1)
        vb = lax.dynamic_slice_in_dim(vw_pad, start, WINDOW + Q_BLOCK, axis=1)
        kpos = start - WINDOW + jnp.arange(WINDOW + Q_BLOCK)
        tq = start + jnp.arange(Q_BLOCK)
        mask = (kpos[None, :] <= tq[:, None]) & (kpos[None, :] > tq[:, None] - WINDOW) & (kpos[None, :] >= 0)
        lg = jnp.einsum('bqghd,bkgd->bgqhk', qb, kb) * scale
        p = masked_softmax(lg, mask[:, None, :]).astype(vb.dtype)
        return jnp.einsum('bgqhk,bkgd->bqghd', p, vb)

    o_w = lax.map(win_step, (q_blk, jnp.arange(n_q)))
    o_w = jnp.moveaxis(o_w, 0, 1).reshape(B, S, NSA_HEADS, DH)

    g = jax.nn.sigmoid(gate_logits.reshape(B, S, NSA_HEADS, 3)).astype(q.dtype)
    o = g[..., 0:1] * o_c + g[..., 1:2] * o_s + g[..., 2:3] * o_w
    return o.reshape(B, S, NSA_HEADS * DH)


def fox_mixer(q, k, v, f_logit, f_bias):
    B, S = q.shape[:2]
    H, DH = FOX_HEADS, HEAD_DIM
    scale = DH ** -0.5
    n_q = S // Q_BLOCK
    q, k, v = [a.reshape(B, S, H, DH) for a in (q, k, v)]
    log_f = jax.nn.log_sigmoid(f_logit.astype(jnp.float32) + f_bias.astype(jnp.float32))
    c = lax.cumsum(log_f, axis=1).transpose(0, 2, 1)
    q_blk = jnp.moveaxis(q.reshape(B, n_q, Q_BLOCK, H, DH), 1, 0)
    c_blk = jnp.moveaxis(c.reshape(B, H, n_q, Q_BLOCK), 2, 0)
    kpos = jnp.arange(S)

    def step(args):
        qb, cq, i = args
        tq = i * Q_BLOCK + jnp.arange(Q_BLOCK)
        lg = jnp.einsum('bqhd,bshd->bhqs', qb, k).astype(jnp.float32) * scale + (cq[..., None] - c[:, :, None, :])
        p = masked_softmax(lg, kpos[None, :] <= tq[:, None]).astype(v.dtype)
        return jnp.einsum('bhqs,bshd->bqhd', p, v)

    o = lax.map(step, (q_blk, c_blk, jnp.arange(n_q)))
    return jnp.moveaxis(o, 0, 1).reshape(B, S, H * DH)


def moe(h, router_w, router_b, w1, b1, w2, b2):
    B, S, D = h.shape
    T = B * S
    xt = h.reshape(T, D)
    logits = (xt @ router_w + router_b).astype(jnp.float32)
    top_v, top_i = lax.top_k(logits, TOP_K)
    gate = jax.nn.softmax(top_v, axis=-1)
    A = T * TOP_K
    flat_e = top_i.reshape(A)
    flat_tok = jnp.repeat(jnp.arange(T, dtype=jnp.int32), TOP_K)
    flat_w = gate.reshape(A)
    order = jnp.argsort(flat_e, stable=True)
    se, stok, sw = flat_e[order], flat_tok[order], flat_w[order]
    counts = jnp.zeros((N_EXPERTS,), jnp.int32).at[flat_e].add(1)
    padded = (counts + MOE_BLOCK - 1) // MOE_BLOCK * MOE_BLOCK
    start = jnp.cumsum(counts) - counts
    pend = jnp.cumsum(padded)
    pstart = pend - padded
    dest = pstart[se] + jnp.arange(A, dtype=jnp.int32) - start[se]
    nb = -(-A // MOE_BLOCK) + N_EXPERTS
    buf_tok = jnp.full((nb * MOE_BLOCK,), T, jnp.int32).at[dest].set(stok)
    buf_w = jnp.zeros((nb * MOE_BLOCK,), jnp.float32).at[dest].set(sw)
    blk_e = jnp.minimum(jnp.searchsorted(pend, jnp.arange(nb, dtype=jnp.int32) * MOE_BLOCK, side='right'), N_EXPERTS - 1)
    xin = jnp.concatenate([xt, jnp.zeros((1, D), xt.dtype)], axis=0)[buf_tok].reshape(nb, MOE_BLOCK, D)

    def expert_block(args):
        xb, e = args
        hc = xb @ w1[e] + b1[e]
        gt = jnp.minimum(hc[:, :D_FF], SWIGLU_LIMIT)
        up = jnp.clip(hc[:, D_FF:], -SWIGLU_LIMIT, SWIGLU_LIMIT)
        glu = gt * jax.nn.sigmoid(SWIGLU_ALPHA * gt)
        return ((up + 1.0) * glu) @ w2[e] + b2[e]

    y = lax.map(expert_block, (xin, blk_e)).reshape(nb * MOE_BLOCK, D)
    y = y * buf_w[:, None].astype(y.dtype)
    out = jnp.zeros((T + 1, D), y.dtype).at[buf_tok].add(y)[:T]
    return out.reshape(B, S, D)


def setup_inputs(seed: int = 0) -> dict:
    key = jax.random.key(seed)
    ks = jax.random.split(key, 20)
    L, D, E, F = DEPTH, D_MODEL, N_EXPERTS, D_FF
    nrm = lambda k, shape: jax.random.normal(k, shape, jnp.float32)
    return {
        'x': nrm(ks[0], (BATCH, SEQ, D)),
        'positions': jax.random.randint(ks[1], (BATCH, 1), 0, 1024, jnp.int32) + jnp.arange(SEQ, dtype=jnp.int32)[None, :],
        'norm1_g': 1.0 + 0.02 * nrm(ks[2], (L, D)),
        'w_in': nrm(ks[3], (L, D, IN_COLS)) * D ** -0.5,
        'cmp_pos_emb': 0.1 * nrm(ks[4], (L, 2, CMP_BLOCK, HEAD_DIM)),
        'cmp_w1': nrm(ks[5], (L, 2, CMP_BLOCK * HEAD_DIM, HEAD_DIM)) * (CMP_BLOCK * HEAD_DIM) ** -0.5,
        'cmp_w2': nrm(ks[6], (L, 2, HEAD_DIM, HEAD_DIM)) * HEAD_DIM ** -0.5,
        'fox_f_bias': 2.0 + 0.5 * nrm(ks[7], (L, FOX_HEADS)),
        'w_proj_nsa': nrm(ks[8], (L, NSA_Q, D)) * NSA_Q ** -0.5,
        'w_proj_fox': nrm(ks[9], (L, FOX_W, D)) * FOX_W ** -0.5,
        'w_out': nrm(ks[10], (L, D, D)) * D ** -0.5,
        'norm2_g': 1.0 + 0.02 * nrm(ks[11], (L, D)),
        'router_w': nrm(ks[12], (L, D, E)) * D ** -0.5,
        'router_b': 0.01 * nrm(ks[13], (L, E)),
        'expert_w1': nrm(ks[14], (L, E, D, 2 * F)) * D ** -0.5,
        'expert_b1': 0.01 * nrm(ks[15], (L, E, 2 * F)),
        'expert_w2': nrm(ks[16], (L, E, F, D)) * F ** -0.5,
        'expert_b2': 0.01 * nrm(ks[17], (L, E, D)),
        'norm_f_g': 1.0 + 0.02 * nrm(ks[18], (D,)),
    }


def reference(x, positions, norm1_g, w_in, cmp_pos_emb, cmp_w1, cmp_w2, fox_f_bias, w_proj_nsa, w_proj_fox, w_out, norm2_g, router_w, router_b, expert_w1, expert_b1, expert_w2, expert_b2, norm_f_g):
    for l in range(DEPTH):
        h = rms_norm(x, norm1_g[l])
        (nq, nkc, nvc, nks, nvs, nkw, nvw, ngate, fq, fk, fv, ff, gate_nsa, gate_fox) = jnp.split(h @ w_in[l], IN_SPLITS, axis=-1)
        o_nsa = nsa_mixer(nq, nkc, nvc, nks, nvs, nkw, nvw, ngate, positions, cmp_pos_emb[l], cmp_w1[l], cmp_w2[l])
        o_fox = fox_mixer(fq, fk, fv, ff, fox_f_bias[l])
        mixed = jax.nn.sigmoid(gate_nsa) * (o_nsa @ w_proj_nsa[l]) + jax.nn.sigmoid(gate_fox) * (o_fox @ w_proj_fox[l])
        x = x + mixed @ w_out[l]
        x = x + moe(rms_norm(x, norm2_g[l]), router_w[l], router_b[l], expert_w1[l], expert_b1[l], expert_w2[l], expert_b2[l])
    return rms_norm(x, norm_f_g)
```

```cpp
#include <hip/hip_runtime.h>
#include <cstdio>
#include <cstdint>

#ifndef PG8_WGM
#define PG8_WGM 8
#endif
namespace pg8 {
#define PG8_LAS __attribute__((address_space(3)))
typedef unsigned short bf16_t;
typedef short bf16x8 __attribute__((ext_vector_type(8)));
typedef float f32x4 __attribute__((ext_vector_type(4)));
typedef unsigned u32x4 __attribute__((ext_vector_type(4)));
typedef int i32x4 __attribute__((ext_vector_type(4)));
typedef int i32x8 __attribute__((ext_vector_type(8)));
constexpr int SIDE_OFF = 131072 + 4096;
constexpr int BM = 256, BK = 64, HALF = 128, HTB = HALF * BK * 2  , STAGE_BYTES = 8 * HTB, NXCD = 8, WGM = PG8_WGM;

__host__ __device__ __forceinline__ int lds_byte(int r, int c) { const int st = (r >> 4) * 2 + (c >> 5), rr = r & 15, cc = c & 31, ob = rr * 64 + cc * 2; return st * 1024 + (ob ^ (((ob >> 9) & 1) << 5)); }
__host__ __device__ __forceinline__ void stage_rc(int b, int& R, int& C) { const int st = b / 1024, sb = b % 1024, swz = sb ^ (((sb >> 9) & 1) << 5); R = (st >> 1) * 16 + swz / 64; C = (st & 1) * 32 + (swz % 64) / 2; }
__host__ __device__ __forceinline__ int perm32(int rho) { const int n = rho >> 4, i = rho & 15; return 8 * (i >> 2) + 4 * n + (i & 3); }

struct Unit { int pm, pn; };
struct Gemm { const bf16_t* A; const bf16_t* Bt; int K, lda, ldb; const int* rowmap; int epi2; };

struct StaticOrder {
    int nM, nN, nwg, G, c, reps;
    __host__ __device__ void init(int M, int N, int G_, int c_, int reps_ = 1) { nM = M / BM; nN = N / BM; nwg = nM * nN; G = G_; c = c_; reps = reps_; }
    __host__ __device__ bool next(int i, Unit& u) const {
        const long L = (long)i * G + c; if (L >= (long)nwg * reps) return false;
        int wgid = (int)(L % nwg); { const int q = nwg / NXCD, r = nwg % NXCD, xcd = wgid % NXCD, off = wgid / NXCD; wgid = (xcd < r ? xcd * (q + 1) : r * (q + 1) + (xcd - r) * q) + off; }
        const int nig = WGM * nN, gid = wgid / nig, fm = gid * WGM, gsz = (nM - fm) < WGM ? (nM - fm) : WGM;
        u.pm = fm + ((wgid % nig) % gsz); u.pn = (wgid % nig) / gsz; return true;
    }
};
struct MoeOrder {
    int nM, nN, nwg, G, c, reps; const PG8_LAS int* tile_e;
    __device__ void init(int nM_, int nN_, int G_, int c_, const PG8_LAS int* te, int reps_ = 1) { nM = nM_; nN = nN_; nwg = nM * nN; G = G_; c = c_; tile_e = te; reps = reps_; }
    __device__ bool next(int i, Unit& u) const {
        const long L = (long)i * G + c; if (L >= (long)nwg * reps) return false;
        int wgid = (int)(L % nwg); { const int q = nwg / NXCD, r = nwg % NXCD, xcd = wgid % NXCD, off = wgid / NXCD; wgid = (xcd < r ? xcd * (q + 1) : r * (q + 1) + (xcd - r) * q) + off; }
        const int nig = WGM * nN, gid = wgid / nig, fm = gid * WGM, gsz = (nM - fm) < WGM ? (nM - fm) : WGM;
        const int pm = fm + ((wgid % nig) % gsz), pn = (wgid % nig) / gsz;
        const int e = __builtin_amdgcn_readfirstlane(tile_e[pm]);
        u.pm = pm; u.pn = e * nN + pn; return true;
    }
};

typedef float f32x2_t __attribute__((ext_vector_type(2))); typedef __bf16 bf16x2_t __attribute__((ext_vector_type(2)));
__device__ __forceinline__ unsigned cvt_pk_bf16(float lo, float hi) { f32x2_t v = {lo, hi}; bf16x2_t b = __builtin_convertvector(v, bf16x2_t); return __builtin_bit_cast(unsigned, b); }

template <class Epi, class Sched, bool ALIGN_EPI, int FP8 = 0, bool GATHER = false>
__device__ __forceinline__ void gemm_phase(PG8_LAS unsigned char* lds, const Gemm g, const Sched& S, const Epi& E) {
    const int tid = threadIdx.x, wid = __builtin_amdgcn_readfirstlane(tid >> 6), lane = tid & 63, wr = wid >> 2, wc = wid & 3, fr = lane & 15, fq = lane >> 4;
    const int K = g.K, nt = K / BK;
    unsigned voffA[2], voffB[2];
#pragma unroll
    for (int i = 0; i < 2; ++i) { int R, C; stage_rc(tid * 16 + i * 8192, R, C); const int Rb = Epi::PERM ? ((R & ~31) + perm32(R & 31)) : R;
        voffA[i] = (unsigned)(R * g.lda + C) * 2u; voffB[i] = (unsigned)(Rb * g.ldb + C) * 2u; }
    unsigned goffC[2][2], goffN[2][2];
#define PG8_GOFF(dst, pm_) do { _Pragma("unroll") for (int i_ = 0; i_ < 2; ++i_) { int R_, C_; stage_rc(tid * 16 + i_ * 8192, R_, C_);   \
        _Pragma("unroll") for (int h_ = 0; h_ < 2; ++h_) dst[h_][i_] = (unsigned)g.rowmap[(pm_) * BM + h_ * HALF + R_] * (unsigned)(g.lda * 2) + (unsigned)C_ * 2u; } } while (0)
    const size_t kstep = (size_t)(BK * 2);
    const size_t hstepA = (size_t)HALF * g.lda * 2, hstepB = (size_t)HALF * g.ldb * 2;
    const size_t tstepA = 2 * hstepA, tstepB = 2 * hstepB;
    const unsigned ldsw = (unsigned)wid * 1024u;
    const int aoff = lds_byte(wr * 64 + fr, fq * 8), boff = lds_byte(wc * 32 + fr, fq * 8);
#define PG8_SA(b, h) (((b) * 2 + (h)) * HTB)
#define PG8_SB(b, h) ((4 + (b) * 2 + (h)) * HTB)
#define PG8_STAGE(bufoff, gbase, voff) do { _Pragma("unroll") for (int _i = 0; _i < 2; ++_i) \
        __builtin_amdgcn_global_load_lds((const unsigned*)((const char*)(gbase) + (voff)[_i]), (PG8_LAS unsigned*)(lds + (bufoff) + ldsw + _i * 8192), 16, 0, 0); } while (0)
#define PG8_STAGE_A(bufoff, ptr_, kb_, h_, useN_) do { if constexpr (GATHER) { _Pragma("unroll") for (int _i = 0; _i < 2; ++_i) \
        __builtin_amdgcn_global_load_lds((const unsigned*)((const char*)g.A + (kb_) + ((useN_) ? goffN[h_][_i] : goffC[h_][_i])), (PG8_LAS unsigned*)(lds + (bufoff) + ldsw + _i * 8192), 16, 0, 0); } \
        else PG8_STAGE(bufoff, ptr_, voffA); } while (0)
#define PG8_LDA(dst, b, h) do { if constexpr (FP8 != 0) { _Pragma("unroll") for (int m = 0; m < 4; ++m) { const i32x4 lo_ = *(const PG8_LAS i32x4*)(lds + PG8_SA(b, h) + aoff + m * 2048), hi_ = *(const PG8_LAS i32x4*)(lds + PG8_SA(b, h) + aoff + m * 2048 + 1024); A8[m] = __builtin_shufflevector(lo_, hi_, 0, 1, 2, 3, 4, 5, 6, 7); } } \
        else { _Pragma("unroll") for (int m = 0; m < 4; ++m) _Pragma("unroll") for (int k = 0; k < 2; ++k) dst[m][k] = *(const PG8_LAS bf16x8*)(lds + PG8_SA(b, h) + aoff + m * 2048 + k * 1024); } } while (0)
#define PG8_LDB(dst, b, h) do { if constexpr (FP8 != 0) { _Pragma("unroll") for (int n = 0; n < 2; ++n) { const i32x4 lo_ = *(const PG8_LAS i32x4*)(lds + PG8_SB(b, h) + boff + n * 2048), hi_ = *(const PG8_LAS i32x4*)(lds + PG8_SB(b, h) + boff + n * 2048 + 1024); dst##8[n] = __builtin_shufflevector(lo_, hi_, 0, 1, 2, 3, 4, 5, 6, 7); } } \
        else { _Pragma("unroll") for (int n = 0; n < 2; ++n) _Pragma("unroll") for (int k = 0; k < 2; ++k) dst[n][k] = *(const PG8_LAS bf16x8*)(lds + PG8_SB(b, h) + boff + n * 2048 + k * 1024); } } while (0)
#ifdef MMA_TWICE
#define PG8_MMA_EXTRA(acc_, b_, a_) asm volatile("v_mfma_scale_f32_16x16x128_f8f6f4 %0, %1, %2, %0, %3, %3 op_sel_hi:[0,0,0]" : "+v"(acc_) : "v"(b_), "v"(a_), "v"(sclZ_));
#else
#define PG8_MMA_EXTRA(acc_, b_, a_)
#endif
#define PG8_MMA(ai, bj, At, Bt) do { __builtin_amdgcn_s_setprio(1); _Pragma("unroll") for (int m = 0; m < 4; ++m) _Pragma("unroll") for (int n = 0; n < 2; ++n) { \
        if constexpr (FP8 != 0) { asm volatile("v_mfma_scale_f32_16x16x128_f8f6f4 %0, %1, %2, %0, %3, %4 op_sel_hi:[0,0,0]" : "+v"(acc[ai][bj][m][n]) : "v"(Bt##8[n]), "v"(A8[m]), "v"(sclB_), "v"(sclA_));   \
          PG8_MMA_EXTRA(acc[ai][bj][m][n], Bt##8[n], A8[m]) } \
        else { _Pragma("unroll") for (int k = 0; k < 2; ++k) acc[ai][bj][m][n] = __builtin_amdgcn_mfma_f32_16x16x32_bf16(Bt[n][k], At[m][k], acc[ai][bj][m][n], 0, 0, 0); } } \
        __builtin_amdgcn_s_setprio(0); } while (0)
#define PG8_WAIT_V(n) asm volatile("s_waitcnt vmcnt(" #n ")" ::: "memory")
#define PG8_WAIT_L(n) asm volatile("s_waitcnt lgkmcnt(" #n ")" ::: "memory")
#define PG8_BAR __builtin_amdgcn_s_barrier()
#define PG8_SCHED __builtin_amdgcn_sched_barrier(0)
    Unit cur, nxt; int ui = 0;
    if (!S.next(0, cur)) return;
    f32x4 acc[2][2][4][2];
#pragma unroll
    for (int a = 0; a < 2; ++a)
#pragma unroll
        for (int b = 0; b < 2; ++b)
#pragma unroll
            for (int m = 0; m < 4; ++m)
#pragma unroll
                for (int n = 0; n < 2; ++n) acc[a][b][m][n] = (f32x4){0.f, 0.f, 0.f, 0.f};
    const int sclB_ = 0x79797979, sclA_ = FP8; const int sclZ_ = 0; (void)sclZ_;
    bf16x8 At[4][2], B0[2][2], B1[2][2]; i32x8 A8[4], B08[2], B18[2];
    const char* cA = (const char*)g.A + (size_t)cur.pm * tstepA; const char* cB = (const char*)g.Bt + (size_t)cur.pn * tstepB;
    if constexpr (GATHER) { PG8_GOFF(goffC, cur.pm); _Pragma("unroll") for (int h_ = 0; h_ < 2; ++h_) _Pragma("unroll") for (int i_ = 0; i_ < 2; ++i_) goffN[h_][i_] = goffC[h_][i_]; }
    PG8_STAGE(PG8_SB(0, 0), cB, voffB); PG8_STAGE(PG8_SB(0, 1), cB + hstepB, voffB); PG8_STAGE_A(PG8_SA(0, 0), cA, 0, 0, false); PG8_STAGE_A(PG8_SA(0, 1), cA + hstepA, 0, 1, false);
    if (wr == 1) PG8_BAR;
    PG8_WAIT_V(2); PG8_BAR;
    PG8_STAGE(PG8_SB(1, 0), cB + kstep, voffB); PG8_STAGE_A(PG8_SA(1, 0), cA + kstep, kstep, 0, false); PG8_STAGE(PG8_SB(1, 1), cB + hstepB + kstep, voffB);
    PG8_WAIT_V(6); PG8_BAR;
    for (;;) {
        typename Epi::Pre pre_; E.prefetch(pre_, cur, wc, fq, wid, lane, lds + SIDE_OFF + (ui & 1) * 2048);
        const bool has_next = S.next(ui + 1, nxt);
        const char* nA = has_next ? (const char*)g.A + (size_t)nxt.pm * tstepA : cA; const char* nB = has_next ? (const char*)g.Bt + (size_t)nxt.pn * tstepB : cB;
        if constexpr (GATHER) { if (has_next) PG8_GOFF(goffN, nxt.pm); }

#pragma unroll 1
        for (int t = 0; t < nt; t += 2) {
            const bool last = (t == nt - 2);
            const char* a1 = cA + (size_t)(t + 1) * kstep;
            const char* a2 = last ? nA : cA + (size_t)(t + 2) * kstep; const char* b2 = last ? nB : cB + (size_t)(t + 2) * kstep;
            const char* a3 = a2 + kstep; const char* b3 = b2 + kstep;
            const size_t kb1 = (size_t)(t + 1) * kstep, kb2 = last ? 0 : (size_t)(t + 2) * kstep, kb3 = kb2 + kstep;
            if constexpr (Epi::HAS_MID) { if (t == nt / 2) E.mid(acc, cur, wr, wc, fr, fq); }
            PG8_LDB(B0, 0, 0); PG8_LDB(B1, 0, 1); PG8_SCHED; PG8_LDA(At, 0, 0); PG8_STAGE_A(PG8_SA(1, 1), a1 + hstepA, kb1, 1, false);
            PG8_WAIT_V(8); PG8_WAIT_L(0); PG8_BAR; PG8_MMA(0, 0, At, B0); PG8_MMA(0, 1, At, B1); PG8_BAR; PG8_SCHED;
            PG8_LDA(At, 0, 1); PG8_STAGE(PG8_SB(0, 0), b2, voffB); PG8_STAGE(PG8_SB(0, 1), b2 + hstepB, voffB); PG8_STAGE_A(PG8_SA(0, 0), a2, kb2, 0, last);
            PG8_WAIT_V(8); PG8_WAIT_L(0); PG8_BAR; PG8_MMA(1, 0, At, B0); PG8_MMA(1, 1, At, B1); PG8_BAR; PG8_SCHED;
            PG8_LDB(B0, 1, 0); PG8_LDB(B1, 1, 1); PG8_SCHED; PG8_LDA(At, 1, 0); PG8_STAGE_A(PG8_SA(0, 1), a2 + hstepA, kb2, 1, last);
            PG8_WAIT_V(8); PG8_WAIT_L(0); PG8_BAR; PG8_MMA(0, 0, At, B0); PG8_MMA(0, 1, At, B1); PG8_BAR; PG8_SCHED;
            PG8_LDA(At, 1, 1); PG8_STAGE(PG8_SB(1, 0), b3, voffB); PG8_STAGE(PG8_SB(1, 1), b3 + hstepB, voffB); PG8_STAGE_A(PG8_SA(1, 0), a3, kb3, 0, last);
            PG8_WAIT_V(8); PG8_WAIT_L(0); PG8_BAR; PG8_MMA(1, 0, At, B0); PG8_MMA(1, 1, At, B1); PG8_BAR; PG8_SCHED;
        }
        if constexpr (ALIGN_EPI) { if (wr == 0) PG8_BAR; }
        if constexpr (FP8 != 0) asm volatile("s_nop 15\n\ts_nop 15" ::: "memory");
        E(acc, cur, wr, wc, fr, fq, pre_, lds + SIDE_OFF + (ui & 1) * 2048);
#ifdef EPI_TWICE
        if (g.epi2) E(acc, cur, wr, wc, fr, fq, pre_, lds + SIDE_OFF + (ui & 1) * 2048);
#endif
        if (!has_next) break;
#pragma unroll
        for (int a = 0; a < 2; ++a)
#pragma unroll
            for (int b = 0; b < 2; ++b)
#pragma unroll
                for (int m = 0; m < 4; ++m)
#pragma unroll
                    for (int n = 0; n < 2; ++n) acc[a][b][m][n] = (f32x4){0.f, 0.f, 0.f, 0.f};
        cur = nxt; cA = nA; cB = nB; ++ui;
        if constexpr (GATHER) { _Pragma("unroll") for (int h_ = 0; h_ < 2; ++h_) _Pragma("unroll") for (int i_ = 0; i_ < 2; ++i_) goffC[h_][i_] = goffN[h_][i_]; }
        if constexpr (ALIGN_EPI) { if (wr == 1) PG8_BAR; }
    }
    PG8_WAIT_V(0);
    if constexpr (!ALIGN_EPI) { if (wr == 0) PG8_BAR; }
    PG8_BAR;
#undef PG8_SA
#undef PG8_SB
#undef PG8_STAGE
#undef PG8_STAGE_A
#undef PG8_GOFF
#undef PG8_LDA
#undef PG8_LDB
#undef PG8_MMA
#undef PG8_WAIT_V
#undef PG8_WAIT_L
#undef PG8_BAR
#undef PG8_SCHED
}
}

constexpr int NWAVES = 8;
constexpr int D_MODEL = 1024, BATCH = 16, SEQ = 2048, T = BATCH * SEQ;
constexpr int HD = 64, NSA_H = 8, NSA_G = 2, FOX_H = 8;
constexpr int IN_COLS = 4896, IN_PAD = 5120;
constexpr int N_EXP = 32, TOPK = 4, D_FF = 1024;
constexpr int A_PAD = 139264;
constexpr int MAX_TILES = A_PAD / 256;
constexpr float NORM_EPS = 1e-6f;
constexpr float LOG2E = 1.4426950408889634f;
constexpr float QSCALE = 0.125f * LOG2E;

constexpr size_t MiB = 1u << 20;
constexpr size_t WS_CTL = 0, CTL_ZERO_BYTES = 65536;
constexpr size_t WS_CCONST = 1 * MiB;
constexpr size_t WS_SN = 1 * MiB + 4096;
constexpr size_t WS_WGB = 1 * MiB + 65536;
constexpr size_t WS_TILEE = 1 * MiB + 131072;
constexpr size_t WS_WRB = 1 * MiB + 262144;
constexpr size_t WS_WIN = 2 * MiB;
constexpr size_t WS_WP = 12 * MiB;
constexpr size_t WS_WOUT = 14 * MiB;
constexpr size_t WS_W1C = 16 * MiB;
constexpr size_t WS_CS = 18 * MiB;
constexpr size_t WS_TOKE = 20 * MiB;
constexpr size_t WS_TOKW = 20 * MiB + 524288;
constexpr size_t WS_TOKS = 21 * MiB;
constexpr size_t WS_SLOTW = 21 * MiB + 524288;
constexpr size_t WS_SLOTT = 22 * MiB + 524288;
constexpr size_t WS_SELM = 24 * MiB;
constexpr size_t WS_KCMP = 25 * MiB;
constexpr size_t WS_VCMP = 26 * MiB;
constexpr size_t WS_C2 = 27 * MiB;
constexpr size_t WS_SG = 28 * MiB;
constexpr size_t WS_W1 = 32 * MiB;
constexpr size_t WS_W2 = 160 * MiB;
constexpr size_t WS_X1 = 224 * MiB;
constexpr size_t WS_XIN = 352 * MiB;
constexpr size_t WS_Y = 352 * MiB;
constexpr size_t WS_ACT = 624 * MiB;
constexpr size_t WS_H = 352 * MiB;
constexpr size_t WS_TMP = 352 * MiB;
constexpr size_t WS_QC = 416 * MiB;
constexpr size_t WS_QR = 448 * MiB;
constexpr size_t WS_MX = 416 * MiB;
constexpr size_t WS_KV6 = 480 * MiB;
constexpr size_t WS_F3 = 528 * MiB;
constexpr size_t WS_G2 = 624 * MiB;
constexpr size_t WS_OC = 752 * MiB;
constexpr size_t WS_OW = 784 * MiB;
constexpr size_t WS_AO = 816 * MiB;
constexpr size_t WS_H2 = 896 * MiB;
constexpr size_t WS_END = 960 * MiB;
constexpr int CW_Q0 = 64, CW_Q1 = 128, CW_Q2 = 256, CW_Q3 = 320, CW_QC = 384;
constexpr int CW_CNT = 192;
constexpr int CW_BAR = 4096;

constexpr int RING_OFF = 0, RING_BYTES = 131072;
constexpr int LDSCTL_OFF = 162816, MISC_OFF = LDSCTL_OFF + 320;
constexpr int LDS_BYTES = 163840;

#define GAS __attribute__((address_space(1)))
#define LAS __attribute__((address_space(3)))
typedef unsigned short bf16;
typedef unsigned v4u __attribute__((ext_vector_type(4)));
typedef unsigned v2u __attribute__((ext_vector_type(2)));
typedef float f32x4 __attribute__((ext_vector_type(4)));
typedef float f32x16 __attribute__((ext_vector_type(16)));
typedef short bf16x8 __attribute__((ext_vector_type(8)));
typedef short s16x4 __attribute__((ext_vector_type(4)));
typedef GAS unsigned gu32;
#define RLX_AGENT __ATOMIC_RELAXED, __HIP_MEMORY_SCOPE_AGENT
#define LDS_WAIT() asm volatile("s_waitcnt lgkmcnt(0)" ::: "memory")
#define VM_WAIT() asm volatile("s_waitcnt vmcnt(0)" ::: "memory")
__device__ __forceinline__ unsigned f2bf(float f) { unsigned u = __builtin_bit_cast(unsigned, f); return (u + 0x7fffu + ((u >> 16) & 1u)) >> 16; }
__device__ __forceinline__ unsigned pk2(float lo, float hi) { return pg8::cvt_pk_bf16(lo, hi); }
__device__ __forceinline__ float clamp8(float x) { return __builtin_amdgcn_fmed3f(x, -448.f, 448.f); }
__device__ __forceinline__ unsigned pk4f8(float a, float b, float c, float d) { int p = __builtin_amdgcn_cvt_pk_fp8_f32(clamp8(a), clamp8(b), 0, false); p = __builtin_amdgcn_cvt_pk_fp8_f32(clamp8(c), clamp8(d), p, true); return (unsigned)p; }
__device__ __forceinline__ float bf_lo(unsigned u) { return __builtin_bit_cast(float, u << 16); }
__device__ __forceinline__ float bf_hi(unsigned u) { return __builtin_bit_cast(float, u & 0xffff0000u); }
__device__ __forceinline__ float sigmoidf_(float x) { return __builtin_amdgcn_rcpf(1.f + __builtin_amdgcn_exp2f(-x * LOG2E)); }
__device__ __forceinline__ float wave_sum(float v) {
#pragma unroll
    for (int o = 1; o < 64; o <<= 1) v += __shfl_xor(v, o);
    return v;
}

#define XB_TMO      128
#define XB_XCNT(j)  (256  + 64 * (j))
#define XB_XSUB(j)  (1280 + 64 * (j))
#define XB_XGEN(j)  (2304 + 64 * (j))
#define XB_TOP      3328
#define XB_TOPGEN   3392
#define XCD_BAR_WORDS 3456
#define XB_SPIN_CAP (1u << 18)

__device__ __forceinline__ unsigned xb_ld(unsigned* p)              { return __hip_atomic_load(p, __ATOMIC_RELAXED, __HIP_MEMORY_SCOPE_AGENT); }
__device__ __forceinline__ unsigned xb_add(unsigned* p, unsigned v) { return __hip_atomic_fetch_add(p, v, __ATOMIC_RELAXED, __HIP_MEMORY_SCOPE_AGENT); }
__device__ __forceinline__ unsigned xb_xcc_id() { return (unsigned)__builtin_amdgcn_s_getreg((3 << 11) | 20) & 0xFu; }
#define XB_SPIN(cond, bar) do { unsigned _sp = 0; while (cond) { __builtin_amdgcn_s_sleep(1); \
    if ((++_sp & 255u) == 0u) { if (xb_ld(&(bar)[XB_TMO])) break; if (_sp > XB_SPIN_CAP) { atomicAdd(&(bar)[XB_TMO], 1u); break; } } } } while (0)

struct XcdBarrier {
    unsigned* bar; unsigned x;
    volatile LAS unsigned* st;
};

__device__ __forceinline__ XcdBarrier xcd_barrier_post(unsigned* bar, volatile LAS unsigned* st) {
    XcdBarrier b; b.bar = bar; b.x = xb_xcc_id(); b.st = st;
    if (threadIdx.x == 0) (void)xb_add(&bar[XB_XCNT(b.x)], 1u);
    return b;
}
__device__ __forceinline__ void xcd_barrier_complete(unsigned* bar, unsigned x, unsigned& nloc, unsigned& nx) {
    const unsigned G = gridDim.x * gridDim.y * gridDim.z;
    unsigned sum, cnt, mine, sp = 0u;
    for (;;) {
        sum = 0u; cnt = 0u; mine = 0u;
#pragma unroll
        for (unsigned j = 0; j < 16; ++j) { const unsigned c = xb_ld(&bar[XB_XCNT(j)]); sum += c; cnt += (c > 0u) ? 1u : 0u; mine = (j == x) ? c : mine; }
        if (sum == G) break;
        __builtin_amdgcn_s_sleep(1);
        if ((++sp & 255u) == 0u) { if (xb_ld(&bar[XB_TMO])) break; if (sp > XB_SPIN_CAP) { atomicAdd(&bar[XB_TMO], 1u); break; } }
    }
    nloc = mine > 0u ? mine : 1u; nx = cnt > 0u ? cnt : 1u;
}

__device__ __forceinline__ void xcd_barrier(const XcdBarrier& b) {
    asm volatile("s_waitcnt vmcnt(0)" ::: "memory");
    __syncthreads();
    if (threadIdx.x == 0) {
        unsigned* bar = b.bar;
        __builtin_amdgcn_s_waitcnt(0);
        unsigned nloc = b.st[0], nx = b.st[1];
        if (nloc == 0u) { xcd_barrier_complete(bar, b.x, nloc, nx); b.st[0] = nloc; b.st[1] = nx; }
        const unsigned old = xb_add(&bar[XB_XSUB(b.x)], 1u);
        const unsigned gen = old / nloc;
        if (old + 1u == (gen + 1u) * nloc) {
            __builtin_amdgcn_fence(__ATOMIC_RELEASE, "agent");
            asm volatile("s_waitcnt vmcnt(0)" ::: "memory");
            const unsigned og = xb_add(&bar[XB_TOP], 1u);
            const unsigned tg = og / nx;
            if (og + 1u == (tg + 1u) * nx) xb_add(&bar[XB_TOPGEN], 1u);
            else XB_SPIN(xb_ld(&bar[XB_TOPGEN]) == tg, bar);
            __builtin_amdgcn_fence(__ATOMIC_ACQUIRE, "agent");
            xb_add(&bar[XB_XGEN(b.x)], 1u);
            asm volatile("s_waitcnt vmcnt(0)" ::: "memory");
        } else {
            XB_SPIN(xb_ld(&bar[XB_XGEN(b.x)]) == gen, bar);
            __builtin_amdgcn_fence(__ATOMIC_ACQUIRE, "agent");
            asm volatile("s_waitcnt vmcnt(0)" ::: "memory");
        }
    }
    __syncthreads();
}
namespace epi {
using pg8::Unit; using pg8::f32x4;
__device__ __forceinline__ void st8(bf16* p, const float* v) { v4u w; w.x = pk2(v[0], v[1]); w.y = pk2(v[2], v[3]); w.z = pk2(v[4], v[5]); w.w = pk2(v[6], v[7]); *(v4u*)p = w; }
__device__ __forceinline__ void ld8(const bf16* p, float* v) { const v4u w = *(const v4u*)p; v[0] = bf_lo(w.x); v[1] = bf_hi(w.x); v[2] = bf_lo(w.y); v[3] = bf_hi(w.y); v[4] = bf_lo(w.z); v[5] = bf_hi(w.z); v[6] = bf_lo(w.w); v[7] = bf_hi(w.w); }

__device__ __forceinline__ v4u widen16(v2u a, v2u b) {
    const auto r0 = __builtin_amdgcn_permlane16_swap(a.x, b.x, false, false), r1 = __builtin_amdgcn_permlane16_swap(a.y, b.y, false, false);
    return (v4u){(unsigned)r0[0], (unsigned)r1[0], (unsigned)r0[1], (unsigned)r1[1]};
}

struct NoPre {};
struct InProj {
    static constexpr bool PERM = true; typedef NoPre Pre; static constexpr bool HAS_MID = false; __device__ __forceinline__ void prefetch(Pre&, const Unit&, int, int, int, int, PG8_LAS unsigned char*) const {}
    bf16* Qc; bf16* Qr; bf16* KV6; bf16* F3; bf16* G2; float* SG; const float* CS; const float* fbias;
    template <int KIND>
    __device__ __forceinline__ void half(const f32x4 (&acc)[2][2][4][2], int bj, int rowb, bf16* dst, int ldd, bf16* dst2, int wc, int fr, int fq) const {
        int cw = wc * 32 + 8 * fq; asm volatile("" : "+v"(cw));
        const bool ropeW = (KIND <= 1) && ((wc & 1) == 0);
#pragma unroll
        for (int ai = 0; ai < 2; ++ai)
#pragma unroll
            for (int m = 0; m < 4; ++m) {
                const int row = rowb + ai * 128 + m * 16;
                float v[8];
#pragma unroll
                for (int j = 0; j < 4; ++j) { v[j] = acc[ai][bj][m][0][j]; v[4 + j] = acc[ai][bj][m][1][j]; }
                if (KIND == 0 || KIND == 3) {
#pragma unroll
                    for (int j = 0; j < 8; ++j) v[j] *= QSCALE;
                }
                if (KIND == 4) {
#pragma unroll
                    for (int j = 0; j < 8; ++j) v[j] = sigmoidf_(v[j]);
                }
                if (KIND == 5) {
                    if (wc == 0) {
                        float o[8];
                        if (fq < 3) {
#pragma unroll
                            for (int j = 0; j < 8; ++j) o[j] = sigmoidf_(v[j]);
                        } else {
#pragma unroll
                            for (int j = 0; j < 8; ++j) { const float x = v[j] + fbias[j]; o[j] = -__builtin_amdgcn_logf(1.f + __builtin_amdgcn_exp2f(-x * LOG2E)); }
                        }
                        *(f32x4*)(SG + (size_t)row * 32 + cw) = (f32x4){o[0], o[1], o[2], o[3]};
                        *(f32x4*)(SG + (size_t)row * 32 + cw + 4) = (f32x4){o[4], o[5], o[6], o[7]};
                    }
                    continue;
                }
                if (KIND == 0) st8(dst + (size_t)row * ldd + cw, v);
                if (KIND <= 1) {
                    float r[8];
#pragma unroll
                    for (int j = 0; j < 8; ++j) r[j] = v[j];
                    if (ropeW) {
                        const f32x4 c0 = *(const f32x4*)(CS + (size_t)row * 16), c1 = *(const f32x4*)(CS + (size_t)row * 16 + 4);
                        const f32x4 s0 = *(const f32x4*)(CS + (size_t)row * 16 + 8), s1 = *(const f32x4*)(CS + (size_t)row * 16 + 12);
                        const float cs_[8] = {c0[0], c0[1], c0[2], c0[3], c1[0], c1[1], c1[2], c1[3]};
                        const float sn_[8] = {s0[0], s0[1], s0[2], s0[3], s1[0], s1[1], s1[2], s1[3]};
#pragma unroll
                        for (int j = 0; j < 8; ++j) {
                            const float w = __shfl_xor(v[j], 16);
                            const float ro = (fq == 0) ? (v[j] * cs_[j] - w * sn_[j]) : (v[j] * cs_[j] + w * sn_[j]);
                            r[j] = (fq < 2) ? ro : v[j];
                        }
                    }
                    st8((KIND == 0 ? dst2 : dst) + (size_t)row * ldd + cw, r);
                } else st8(dst + (size_t)row * ldd + cw, v);
            }
    }
    __device__ __forceinline__ void operator()(const f32x4 (&acc)[2][2][4][2], const Unit& u, int wr, int wc, int fr, int fq, const Pre& pre, PG8_LAS unsigned char* side) const {
        int rowb = u.pm * 256 + wr * 64 + fr; asm volatile("" : "+v"(rowb));
#pragma unroll
        for (int bj = 0; bj < 2; ++bj) {
            const int U = u.pn * 2 + bj;
            if (U < 4) half<0>(acc, bj, rowb, Qc + U * 128, 512, Qr + U * 128, wc, fr, fq);
            else if (U == 6 || U == 8) half<1>(acc, bj, rowb, KV6 + (size_t)(U - 4) * T * 128, 128, nullptr, wc, fr, fq);
            else if (U < 10) half<2>(acc, bj, rowb, KV6 + (size_t)(U - 4) * T * 128, 128, nullptr, wc, fr, fq);
            else if (U < 14) half<3>(acc, bj, rowb, F3 + (U - 10) * 128, 512, nullptr, wc, fr, fq);
            else if (U < 22) half<2>(acc, bj, rowb, F3 + (size_t)((U - 10) >> 2) * T * 512 + ((U - 10) & 3) * 128, 512, nullptr, wc, fr, fq);
            else if (U < 38) half<4>(acc, bj, rowb, G2 + (size_t)((U - 22) >> 3) * T * 1024 + ((U - 22) & 7) * 128, 1024, nullptr, wc, fr, fq);
            else if (U == 38) half<5>(acc, bj, rowb, nullptr, 0, nullptr, wc, fr, fq);
        }
    }
};

struct Gate1 {
    static constexpr bool PERM = true; typedef NoPre Pre; static constexpr bool HAS_MID = false; __device__ __forceinline__ void prefetch(Pre&, const Unit&, int, int, int, int, PG8_LAS unsigned char*) const {}
    const bf16* GN; bf16* TMP;
    __device__ __forceinline__ void operator()(const f32x4 (&acc)[2][2][4][2], const Unit& u, int wr, int wc, int fr, int fq, const Pre& pre, PG8_LAS unsigned char* side) const {
#pragma unroll
        for (int ai = 0; ai < 2; ++ai)
#pragma unroll
            for (int m = 0; m < 4; ++m) {
                const int row = u.pm * 256 + ai * 128 + wr * 64 + m * 16 + fr;
#pragma unroll
                for (int bj = 0; bj < 2; ++bj) {
                    const size_t off = (size_t)row * 1024 + u.pn * 256 + bj * 128 + wc * 32 + 8 * fq;
                    float g[8], v[8]; ld8(GN + off, g);
#pragma unroll
                    for (int j = 0; j < 4; ++j) { v[j] = acc[ai][bj][m][0][j] * g[j]; v[4 + j] = acc[ai][bj][m][1][j] * g[4 + j]; }
                    st8(TMP + off, v);
                }
            }
    }
};
struct Gate2 {
    static constexpr bool PERM = true; typedef NoPre Pre; static constexpr bool HAS_MID = false; __device__ __forceinline__ void prefetch(Pre&, const Unit&, int, int, int, int, PG8_LAS unsigned char*) const {}
    const bf16* GF; const bf16* TMP; bf16* MX;
    __device__ __forceinline__ void operator()(const f32x4 (&acc)[2][2][4][2], const Unit& u, int wr, int wc, int fr, int fq, const Pre& pre, PG8_LAS unsigned char* side) const {
#pragma unroll
        for (int ai = 0; ai < 2; ++ai)
#pragma unroll
            for (int m = 0; m < 4; ++m) {
                const int row = u.pm * 256 + ai * 128 + wr * 64 + m * 16 + fr;
#pragma unroll
                for (int bj = 0; bj < 2; ++bj) {
                    const size_t off = (size_t)row * 1024 + u.pn * 256 + bj * 128 + wc * 32 + 8 * fq;
                    float g[8], t[8], v[8]; ld8(GF + off, g); ld8(TMP + off, t);
#pragma unroll
                    for (int j = 0; j < 4; ++j) { v[j] = t[j] + acc[ai][bj][m][0][j] * g[j]; v[4 + j] = t[4 + j] + acc[ai][bj][m][1][j] * g[4 + j]; }
                    st8(MX + off, v);
                }
            }
    }
};
struct GateMix {
    static constexpr bool PERM = true; static constexpr bool HAS_MID = true; typedef NoPre Pre;
    const bf16* GN; const bf16* GF; bf16* MX;
    __device__ __forceinline__ void prefetch(Pre&, const Unit&, int, int, int, int, PG8_LAS unsigned char*) const {}
    __device__ __forceinline__ void mid(f32x4 (&acc)[2][2][4][2], const Unit& u, int wr, int wc, int fr, int fq) const {
        int opq = 0; asm volatile("" : "+v"(opq));
#pragma unroll
        for (int ai = 0; ai < 2; ++ai)
#pragma unroll
            for (int m = 0; m < 4; ++m) {
                const int row = u.pm * 256 + ai * 128 + wr * 64 + m * 16 + fr + opq;
#pragma unroll
                for (int bj = 0; bj < 2; ++bj) {
                    const size_t off = (size_t)row * 1024 + u.pn * 256 + bj * 128 + wc * 32 + 8 * fq;
                    float a[8], b[8]; ld8(GN + off, a); ld8(GF + off, b);
#pragma unroll
                    for (int j = 0; j < 4; ++j) { acc[ai][bj][m][0][j] *= a[j] * __builtin_amdgcn_rcpf(b[j]); acc[ai][bj][m][1][j] *= a[4 + j] * __builtin_amdgcn_rcpf(b[4 + j]); }
                }
                asm volatile("" ::: "memory");
            }
    }
    __device__ __forceinline__ void operator()(const f32x4 (&acc)[2][2][4][2], const Unit& u, int wr, int wc, int fr, int fq, const Pre&, PG8_LAS unsigned char* side) const {
#pragma unroll
        for (int ai = 0; ai < 2; ++ai)
#pragma unroll
            for (int m = 0; m < 4; ++m) {
                const int row = u.pm * 256 + ai * 128 + wr * 64 + m * 16 + fr;
#pragma unroll
                for (int bj = 0; bj < 2; ++bj) {
                    const size_t off = (size_t)row * 1024 + u.pn * 256 + bj * 128 + wc * 32 + 8 * fq;
                    float b[8], v[8]; ld8(GF + off, b);
#pragma unroll
                    for (int j = 0; j < 4; ++j) { v[j] = acc[ai][bj][m][0][j] * b[j]; v[4 + j] = acc[ai][bj][m][1][j] * b[4 + j]; }
                    st8(MX + off, v);
                }
            }
    }
};
struct ResOut {
    static constexpr bool PERM = true; typedef NoPre Pre; static constexpr bool HAS_MID = false; __device__ __forceinline__ void prefetch(Pre&, const Unit&, int, int, int, int, PG8_LAS unsigned char*) const {}
    const float* X; bf16* X1;
    __device__ __forceinline__ void operator()(const f32x4 (&acc)[2][2][4][2], const Unit& u, int wr, int wc, int fr, int fq, const Pre& pre, PG8_LAS unsigned char* side) const {
#pragma unroll
        for (int ai = 0; ai < 2; ++ai)
#pragma unroll
            for (int m = 0; m < 4; ++m) {
                const int row = u.pm * 256 + ai * 128 + wr * 64 + m * 16 + fr;
#pragma unroll
                for (int bj = 0; bj < 2; ++bj) {
                    const size_t off = (size_t)row * 1024 + u.pn * 256 + bj * 128 + wc * 32 + 8 * fq;
                    const f32x4 x0 = *(const f32x4*)(X + off), x1 = *(const f32x4*)(X + off + 4);
                    float v[8];
#pragma unroll
                    for (int j = 0; j < 4; ++j) { v[j] = x0[j] + acc[ai][bj][m][0][j]; v[4 + j] = x1[j] + acc[ai][bj][m][1][j]; }
                    st8(X1 + off, v);
                }
            }
    }
};
struct Moe1 {
    static constexpr bool PERM = true; static constexpr bool HAS_MID = false; typedef NoPre Pre;
    __device__ __forceinline__ void prefetch(Pre&, const Unit& u, int wc, int fq, int wid, int lane, PG8_LAS unsigned char* side) const {
        if (wid == 0) { const int e = u.pn >> 3, ct = u.pn & 7; const float* src = b1 + (size_t)e * 2048 + (lane >> 5) * 1024 + ct * 128 + (lane & 31) * 4;
            __builtin_amdgcn_global_load_lds((const unsigned*)src, (PG8_LAS unsigned*)side, 16, 0, 0); } }
    const float* b1; unsigned char* ACT;
    __device__ __forceinline__ void operator()(const f32x4 (&acc)[2][2][4][2], const Unit& u, int wr, int wc, int fr, int fq, const Pre& pre, PG8_LAS unsigned char* side) const {
        const int e = u.pn >> 3, ct = u.pn & 7, cw = ct * 128 + wc * 32 + 8 * fq;
        const PG8_LAS float* sb = (const PG8_LAS float*)side + wc * 32 + 8 * fq;
        const f32x4 g0 = *(const PG8_LAS f32x4*)sb, g1 = *(const PG8_LAS f32x4*)(sb + 4), u0 = *(const PG8_LAS f32x4*)(sb + 128), u1 = *(const PG8_LAS f32x4*)(sb + 132);
        const int rsel = (fq & 1) * 16, cw16 = ct * 128 + wc * 32 + 16 * (fq >> 1);
#pragma unroll
        for (int ai = 0; ai < 2; ++ai)
#pragma unroll
            for (int mp = 0; mp < 2; ++mp) {
                v2u w[2];
#pragma unroll
                for (int mm = 0; mm < 2; ++mm) { const int m = 2 * mp + mm;
                    float v[8];
#pragma unroll
                    for (int j = 0; j < 8; ++j) {
                        const float ga = (j < 4 ? acc[ai][0][m][0][j & 3] : acc[ai][0][m][1][j & 3]) + (j < 4 ? g0[j & 3] : g1[j & 3]);
                        const float ua = (j < 4 ? acc[ai][1][m][0][j & 3] : acc[ai][1][m][1][j & 3]) + (j < 4 ? u0[j & 3] : u1[j & 3]);
                        const float gt = fminf(ga, 7.0f), up = fminf(fmaxf(ua, -7.0f), 7.0f);
                        v[j] = 4.0f * (up + 1.0f) * gt * sigmoidf_(1.702f * gt);
                    }
                    w[mm].x = pk4f8(v[0], v[1], v[2], v[3]); w[mm].y = pk4f8(v[4], v[5], v[6], v[7]); }
                const int row = u.pm * 256 + ai * 128 + wr * 64 + mp * 32 + rsel + fr;
                *(v4u*)(ACT + (size_t)row * 1024 + cw16) = widen16(w[0], w[1]);
            }
    }
};
struct Moe2 {
    static constexpr bool PERM = true; static constexpr bool HAS_MID = false; typedef NoPre Pre;
    __device__ __forceinline__ void prefetch(Pre&, const Unit& u, int wc, int fq, int wid, int lane, PG8_LAS unsigned char* side) const {
        if (wid == 0) { const int e = u.pn >> 2, ct = u.pn & 3; __builtin_amdgcn_global_load_lds((const unsigned*)(b2 + (size_t)e * 1024 + ct * 256 + lane * 4), (PG8_LAS unsigned*)side, 16, 0, 0); }
        if (wid == 1) { __builtin_amdgcn_global_load_lds((const unsigned*)(SW + (size_t)u.pm * 256 + lane * 4), (PG8_LAS unsigned*)(side + 1024), 16, 0, 0); } }
    const float* b2; const float* SW; unsigned char* Y8;
    __device__ __forceinline__ void operator()(const f32x4 (&acc)[2][2][4][2], const Unit& u, int wr, int wc, int fr, int fq, const Pre& pre, PG8_LAS unsigned char* side) const {
        const int e = u.pn >> 2, ct = u.pn & 3;
#pragma unroll
        for (int bj = 0; bj < 2; ++bj) {
            const int col = ct * 256 + bj * 128 + wc * 32 + 8 * fq;
            const PG8_LAS float* sb = (const PG8_LAS float*)side + bj * 128 + wc * 32 + 8 * fq;
            const f32x4 c0 = *(const PG8_LAS f32x4*)sb, c1 = *(const PG8_LAS f32x4*)(sb + 4);
            const int rsel = (fq & 1) * 16, col16 = ct * 256 + bj * 128 + wc * 32 + 16 * (fq >> 1);
#pragma unroll
            for (int ai = 0; ai < 2; ++ai)
#pragma unroll
                for (int mp = 0; mp < 2; ++mp) {
                    v2u w8[2];
#pragma unroll
                    for (int mm = 0; mm < 2; ++mm) { const int m = 2 * mp + mm;
                        const float w = 16.f * ((const PG8_LAS float*)(side + 1024))[ai * 128 + wr * 64 + m * 16 + fr];
                        float v[8];
#pragma unroll
                        for (int j = 0; j < 4; ++j) { v[j] = (acc[ai][bj][m][0][j] + c0[j]) * w; v[4 + j] = (acc[ai][bj][m][1][j] + c1[j]) * w; }
                        w8[mm].x = pk4f8(v[0], v[1], v[2], v[3]); w8[mm].y = pk4f8(v[4], v[5], v[6], v[7]); }
                    const int row = u.pm * 256 + ai * 128 + wr * 64 + mp * 32 + rsel + fr;
                    *(v4u*)(Y8 + (size_t)row * 1024 + col16) = widen16(w8[0], w8[1]);
                }
        }
    }
};
}

namespace att {
constexpr int LK = 0, LV = 16384, LCK = 32768, LWS = 33280, LOST = 35328, LIMP = 68096, LDS_ATT = 76288;
__device__ __forceinline__ int crow(int r, int hi) { return (r & 3) + 8 * (r >> 2) + 4 * hi; }
__device__ __forceinline__ float xhalf_max(float m) { auto rr = __builtin_amdgcn_permlane32_swap(__float_as_uint(m), __float_as_uint(m), false, false); return fmaxf(__uint_as_float(rr[0]), __uint_as_float(rr[1])); }
__device__ __forceinline__ float xhalf_sum(float m) { auto rr = __builtin_amdgcn_permlane32_swap(__float_as_uint(m), __float_as_uint(m), false, false); return __uint_as_float(rr[0]) + __uint_as_float(rr[1]); }
typedef short v4i16_t __attribute__((ext_vector_type(4)));
__device__ __forceinline__ s16x4 vtr(const LAS char* p) { return __builtin_bit_cast(s16x4, __builtin_amdgcn_ds_read_tr16_b64_v4i16((LAS v4i16_t*)p)); }

__device__ __forceinline__ float max3f_(float a, float b, float c) { float r; asm("v_max3_f32 %0, %1, %2, %3" : "=v"(r) : "v"(a), "v"(b), "v"(c)); return r; }
__device__ __forceinline__ float quad_xor1(float x) { return __uint_as_float(__builtin_amdgcn_update_dpp(0u, __float_as_uint(x), 0xB1, 0xF, 0xF, false)); }
__device__ __forceinline__ float quad_xor2(float x) { return __uint_as_float(__builtin_amdgcn_update_dpp(0u, __float_as_uint(x), 0x4E, 0xF, 0xF, false)); }
__device__ __forceinline__ float xhalf_get(float x) { auto rr = __builtin_amdgcn_permlane32_swap(__float_as_uint(x), __float_as_uint(x), false, false); return __uint_as_float((threadIdx.x & 32) ? rr[0] : rr[1]); }
struct Ptrs {
    unsigned char* ws;
    __device__ __forceinline__ const bf16* Qc() const { return (const bf16*)(ws + WS_QC); }
    __device__ __forceinline__ const bf16* Qr() const { return (const bf16*)(ws + WS_QR); }
    __device__ __forceinline__ const bf16* KV6() const { return (const bf16*)(ws + WS_KV6); }
    __device__ __forceinline__ const bf16* F3() const { return (const bf16*)(ws + WS_F3); }
    __device__ __forceinline__ const float* C2() const { return (const float*)(ws + WS_C2); }
    __device__ __forceinline__ const float* SN() const { return (const float*)(ws + WS_SN); }
    __device__ __forceinline__ unsigned* SELM() const { return (unsigned*)(ws + WS_SELM); }
    __device__ __forceinline__ const float* SG() const { return (const float*)(ws + WS_SG); }
    __device__ __forceinline__ const bf16* KCMP() const { return (const bf16*)(ws + WS_KCMP); }
    __device__ __forceinline__ const bf16* VCMP() const { return (const bf16*)(ws + WS_VCMP); }
    __device__ __forceinline__ bf16* OC() const { return (bf16*)(ws + WS_OC); }
    __device__ __forceinline__ bf16* OW() const { return (bf16*)(ws + WS_OW); }
    __device__ __forceinline__ bf16* AO() const { return (bf16*)(ws + WS_AO); }
};

__device__ __forceinline__ void qkt(f32x16& p0, f32x16& p1, const LAS char* Kb, const bf16x8* qr, int r32, int hi, const f32x16& init) {
    const LAS char* kb = Kb + hi * 1024 + r32 * 16;
    p0 = init; p1 = init;
#pragma unroll
    for (int d0 = 0; d0 < 4; ++d0) {
        const bf16x8 b0 = *(const LAS bf16x8*)(kb + d0 * 2048);
        const bf16x8 b1 = *(const LAS bf16x8*)(kb + d0 * 2048 + 512);
        p0 = __builtin_amdgcn_mfma_f32_32x32x16_bf16(b0, qr[d0], p0, 0, 0, 0);
        p1 = __builtin_amdgcn_mfma_f32_32x32x16_bf16(b1, qr[d0], p1, 0, 0, 0);
    }
}
__device__ __forceinline__ void pv(f32x16* o, const LAS char* vb, const f32x16& p0, const f32x16& p1) {
    v4u pw[4];
#pragma unroll
    for (int i = 0; i < 4; ++i) { pw[0][i] = pk2(p0[2 * i], p0[2 * i + 1]); pw[1][i] = pk2(p0[8 + 2 * i], p0[9 + 2 * i]); pw[2][i] = pk2(p1[2 * i], p1[2 * i + 1]); pw[3][i] = pk2(p1[8 + 2 * i], p1[9 + 2 * i]); }
#pragma unroll
    for (int d0 = 0; d0 < 2; ++d0)
#pragma unroll
        for (int ks = 0; ks < 4; ++ks) {
            const s16x4 lo = vtr(vb + d0 * 4096 + ks * 1024), hh = vtr(vb + d0 * 4096 + ks * 1024 + 512);
            const bf16x8 vf = (bf16x8){lo[0], lo[1], lo[2], lo[3], hh[0], hh[1], hh[2], hh[3]};
            o[d0] = __builtin_amdgcn_mfma_f32_32x32x16_bf16(__builtin_bit_cast(bf16x8, pw[ks]), vf, o[d0], 0, 0, 0);
        }
}
__device__ __forceinline__ void stage_o(const f32x16* o, float l_part, LAS char* lds, int wid, int r32, int hi) {
    LAS float* wsf = (LAS float*)(lds + LWS) + wid * 64;
    const float l = xhalf_sum(l_part);
    if (hi == 0) wsf[32 + r32] = l;
    LDS_WAIT();
    LAS bf16* stg = (LAS bf16*)(lds + LOST) + wid * 2048;
#pragma unroll
    for (int r = 0; r < 16; ++r) {
        const float lr = wsf[32 + crow(r, hi)]; const float inv = lr > 0.f ? __builtin_amdgcn_rcpf(lr) : 0.f; const int orow = crow(r, hi);
        stg[orow * 64 + r32] = (bf16)f2bf(o[0][r] * inv); stg[orow * 64 + 32 + r32] = (bf16)f2bf(o[1][r] * inv);
    }
    LDS_WAIT();
}

template <int MODE>
__device__ __forceinline__ void attn_unit(int b, int h, int qb, const Ptrs& P, LAS char* lds) {
    const int tid = threadIdx.x, lane = tid & 63, r32 = lane & 31, hi = lane >> 5; const int wid = __builtin_amdgcn_readfirstlane(tid >> 6);
    const size_t rowbase = (size_t)b * SEQ; const int q0 = qb * 256, qw0 = q0 + wid * 32, qpos = qw0 + r32;
    const bf16* Qp; const bf16 *Kp, *Vp; int kvp;
    if (MODE == 0) { Qp = P.F3() + (rowbase * 512 + h * 64); Kp = P.F3() + (size_t)T * 512 + (rowbase * 512 + h * 64); Vp = P.F3() + (size_t)2 * T * 512 + (rowbase * 512 + h * 64); kvp = 512; }
    else { const int g = h >> 2; const int ti = (MODE == 1) ? 4 : 2; Qp = P.Qr() + (rowbase * 512 + h * 64);
        Kp = P.KV6() + (size_t)ti * T * 128 + (rowbase * 128 + g * 64); Vp = P.KV6() + (size_t)(ti + 1) * T * 128 + (rowbase * 128 + g * 64); kvp = 128; }
    bf16x8 qr[4];
#pragma unroll
    for (int d0 = 0; d0 < 4; ++d0) qr[d0] = *(const bf16x8*)(Qp + (size_t)qpos * 512 + d0 * 16 + hi * 8);
    float c2q = 0.f; unsigned sm = 0u; const float* c2p = nullptr;
    if (MODE == 0) { c2p = P.C2() + (size_t)(b * 8 + h) * SEQ; c2q = c2p[qpos]; }
    if (MODE == 2) sm = P.SELM()[(size_t)(b * 2 + (h >> 2)) * SEQ + qpos];
    asm volatile("" : "+v"(qr[0]), "+v"(qr[1]), "+v"(qr[2]), "+v"(qr[3]), "+v"(c2q), "+v"(sm));
    int t0 = (MODE == 1) ? (4 * qb - 8 > 0 ? 4 * qb - 8 : 0) : 0; const int t1 = 4 * qb + 4;
    float prune_c = 0.f;
    if (MODE == 0) {
        const float smax = sqrtf(P.SN()[b * 8 + h] * P.SN()[128 + b * 8 + h]);
        const float cq0 = c2p[q0];
        const float ce = c2p[64 * r32 + 63];
        const unsigned long long keep = __ballot(cq0 - ce + 2.f * smax >= -50.f);
        const int first = keep ? (int)__builtin_ctzll(keep) : 0;
        t0 = __builtin_amdgcn_readfirstlane(first < 4 * qb ? first : 4 * qb);
        prune_c = 2.f * smax + 50.f + c2p[qw0];
    }
    const bf16* ksrc = Kp + (size_t)lane * kvp + wid * 8;
    const bf16* vsrc = Vp + (size_t)(16 * (wid & 3) + (lane >> 2)) * kvp + (wid >> 2) * 32 + (lane & 3) * 8;
    const int sdst = wid * 1024 + lane * 16;
    v4u kreg, vreg; float ckreg = 0.f;
    kreg = *(const v4u*)(ksrc + (size_t)t0 * 64 * kvp); vreg = *(const v4u*)(vsrc + (size_t)t0 * 64 * kvp);
    if (MODE == 0 && tid < 64) ckreg = c2p[t0 * 64 + tid];
    __syncthreads();
    *(LAS v4u*)(lds + LK + sdst) = kreg; *(LAS v4u*)(lds + LV + sdst) = vreg;
    if (MODE == 0 && tid < 64) ((LAS float*)(lds + LCK))[tid] = ckreg;
    __syncthreads();
    float mref = 0.f, l = 0.f; f32x16 o[2]; o[0] = f32x16{}; o[1] = f32x16{}; f32x16 negm = f32x16{};
    LAS float* wsf = (LAS float*)(lds + LWS) + wid * 64;
    const int vboff = ((lane >> 4) & 1) * 32 + (lane & 3) * 8 + (4 * hi + ((lane & 15) >> 2)) * 64;
    for (int t = t0; t < t1; ++t) {
        const int cur = (t - t0) & 1;
        if (t + 1 < t1) {
            kreg = *(const v4u*)(ksrc + (size_t)(t + 1) * 64 * kvp); vreg = *(const v4u*)(vsrc + (size_t)(t + 1) * 64 * kvp);
            if (MODE == 0 && tid < 64) ckreg = c2p[(t + 1) * 64 + tid];
        }
        const int kv0 = t * 64;
        bool active = kv0 <= qw0 + 31;
        if (MODE == 1) active = active && (kv0 + 63 > qw0 - 512);
        if (MODE == 0) active = active && (__builtin_amdgcn_readfirstlane(__float_as_uint(prune_c - ((const LAS float*)(lds + LCK + cur * 256))[63])) >> 31) == 0u;
        if (active) {
            f32x16 p0, p1;
            qkt(p0, p1, lds + LK + cur * 8192, qr, r32, hi, negm);
            if (MODE == 0) {
                const LAS float* ck = (const LAS float*)(lds + LCK + cur * 256);
#pragma unroll
                for (int g4 = 0; g4 < 4; ++g4) {
                    const f32x4 a = *(const LAS f32x4*)(ck + 8 * g4 + 4 * hi), bb = *(const LAS f32x4*)(ck + 32 + 8 * g4 + 4 * hi);
#pragma unroll
                    for (int j = 0; j < 4; ++j) { p0[4 * g4 + j] += c2q - a[j]; p1[4 * g4 + j] += c2q - bb[j]; }
                }
            }
            const bool diag = (kv0 + 63 > qw0) || (MODE == 1 && kv0 <= qw0 + 31 - 512);
            if (diag) {
                const bool blk = (MODE == 2) ? ((sm >> t) & 1u) != 0u : true;
#pragma unroll
                for (int r = 0; r < 16; ++r) {
                    const int ka = kv0 + crow(r, hi), kb = ka + 32;
                    bool va = blk && ka <= qpos, vb = blk && kb <= qpos;
                    if (MODE == 1) { va = va && ka > qpos - 512; vb = vb && kb > qpos - 512; }
                    p0[r] = va ? p0[r] : -INFINITY; p1[r] = vb ? p1[r] : -INFINITY;
                }
            } else if (MODE == 2) {
                const bool blk = ((sm >> t) & 1u) != 0u;
#pragma unroll
                for (int r = 0; r < 16; ++r) { p0[r] = blk ? p0[r] : -INFINITY; p1[r] = blk ? p1[r] : -INFINITY; }
            }
            float mx = fmaxf(p0[0], p1[0]);
#pragma unroll
            for (int r = 1; r < 16; ++r) mx = fmaxf(mx, fmaxf(p0[r], p1[r]));
            mx = xhalf_max(mx);
            if (__any(mx > 8.f)) {
                const float dl = fmaxf(mx, 0.f), alpha = __builtin_amdgcn_exp2f(-dl);
                mref += dl; l *= alpha;
#pragma unroll
                for (int r = 0; r < 16; ++r) { p0[r] -= dl; p1[r] -= dl; negm[r] = -mref; }
                if (hi == 0) wsf[r32] = alpha;
                LDS_WAIT();
#pragma unroll
                for (int g4 = 0; g4 < 4; ++g4) {
                    const f32x4 a = *(const LAS f32x4*)(wsf + 8 * g4 + 4 * hi);
#pragma unroll
                    for (int j = 0; j < 4; ++j) { o[0][4 * g4 + j] *= a[j]; o[1][4 * g4 + j] *= a[j]; }
                }
            }
            float s0 = 0.f, s1 = 0.f, s2 = 0.f, s3 = 0.f;
#pragma unroll
            for (int r = 0; r < 16; r += 2) { p0[r] = __builtin_amdgcn_exp2f(p0[r]); p1[r] = __builtin_amdgcn_exp2f(p1[r]); p0[r + 1] = __builtin_amdgcn_exp2f(p0[r + 1]); p1[r + 1] = __builtin_amdgcn_exp2f(p1[r + 1]);
                s0 += p0[r]; s1 += p1[r]; s2 += p0[r + 1]; s3 += p1[r + 1]; }
            l += (s0 + s1) + (s2 + s3);
            pv(o, lds + LV + cur * 8192 + vboff, p0, p1);
        }
        if (t + 1 < t1) {
            *(LAS v4u*)(lds + LK + (cur ^ 1) * 8192 + sdst) = kreg; *(LAS v4u*)(lds + LV + (cur ^ 1) * 8192 + sdst) = vreg;
            if (MODE == 0 && tid < 64) ((LAS float*)(lds + LCK + (cur ^ 1) * 256))[tid] = ckreg;
        }
        __syncthreads();
    }
    stage_o(o, l, lds, wid, r32, hi);
    const LAS bf16* stg = (const LAS bf16*)(lds + LOST) + wid * 2048;
#pragma unroll
    for (int i = 0; i < 4; ++i) {
        const int row = i * 8 + (lane >> 3), ch = lane & 7; const size_t grow = rowbase + qw0 + row;
        const v4u v = *(const LAS v4u*)(stg + row * 64 + ch * 8);
        if (MODE == 0) *(v4u*)(P.AO() + grow * 1024 + 512 + h * 64 + ch * 8) = v;
        else if (MODE == 1) *(v4u*)(P.OW() + grow * 512 + h * 64 + ch * 8) = v;
        else {
            const float g0 = P.SG()[grow * 32 + h * 3 + 0], g1 = P.SG()[grow * 32 + h * 3 + 1], g2 = P.SG()[grow * 32 + h * 3 + 2];
            const v4u vc = *(const v4u*)(P.OC() + grow * 512 + h * 64 + ch * 8), vw = *(const v4u*)(P.OW() + grow * 512 + h * 64 + ch * 8);
            v4u out;
#pragma unroll
            for (int j = 0; j < 4; ++j) {
                const float lo = g0 * bf_lo(vc[j]) + g1 * bf_lo(v[j]) + g2 * bf_lo(vw[j]);
                const float hh = g0 * bf_hi(vc[j]) + g1 * bf_hi(v[j]) + g2 * bf_hi(vw[j]);
                out[j] = pk2(lo, hh);
            }
            *(v4u*)(P.AO() + grow * 1024 + h * 64 + ch * 8) = out;
        }
    }
}

__device__ __forceinline__ void cmp_unit(int b, int g, int qblk, const Ptrs& P, LAS char* lds) {
    const int tid = threadIdx.x, lane = tid & 63, r32 = lane & 31, hi = lane >> 5; const int wid = __builtin_amdgcn_readfirstlane(tid >> 6);
    const size_t rowbase = (size_t)b * SEQ; const int s0 = qblk * 64, tok = s0 + 8 * wid + (r32 >> 2), head = 4 * g + (r32 & 3);
    bf16x8 qr[4];
#pragma unroll
    for (int d0 = 0; d0 < 4; ++d0) qr[d0] = *(const bf16x8*)(P.Qc() + (rowbase + tok) * 512 + head * 64 + d0 * 16 + hi * 8);
    const bf16* Kc = P.KCMP() + (size_t)(b * 2 + g) * 128 * 64; const bf16* Vc = P.VCMP() + (size_t)(b * 2 + g) * 128 * 64;
    __syncthreads();
#pragma unroll
    for (int tt = 0; tt < 2; ++tt) {
        const v4u kreg = *(const v4u*)(Kc + (size_t)(tt * 64 + lane) * 64 + wid * 8);
        const v4u vreg = *(const v4u*)(Vc + (size_t)(tt * 64 + 16 * (wid & 3) + (lane >> 2)) * 64 + (wid >> 2) * 32 + (lane & 3) * 8);
        *(LAS v4u*)(lds + LK + tt * 8192 + wid * 1024 + lane * 16) = kreg; *(LAS v4u*)(lds + LV + tt * 8192 + wid * 1024 + lane * 16) = vreg;
    }
    __syncthreads();
    const int nvalid = tok >= 31 ? ((tok - 31) / 16 + 1 < 127 ? (tok - 31) / 16 + 1 : 127) : 0;
    f32x16 p[4];
    { const f32x16 z16 = f32x16{}; qkt(p[0], p[1], lds + LK, qr, r32, hi, z16); qkt(p[2], p[3], lds + LK + 8192, qr, r32, hi, z16); }
#pragma unroll
    for (int tq = 0; tq < 4; ++tq)
#pragma unroll
        for (int r = 0; r < 16; ++r) { const int c = 32 * tq + crow(r, hi); p[tq][r] = c < nvalid ? p[tq][r] : -INFINITY; }
    float mxa = -INFINITY, mxb = -INFINITY;
#pragma unroll
    for (int tq = 0; tq < 4; ++tq)
#pragma unroll
        for (int r = 0; r < 16; r += 4) { mxa = max3f_(mxa, p[tq][r], p[tq][r + 1]); mxb = max3f_(mxb, p[tq][r + 2], p[tq][r + 3]); }
    float mx = max3f_(mxa, mxb, mxb);
    mx = xhalf_max(mx); if (nvalid == 0) mx = 0.f;
    float s = 0.f;
#pragma unroll
    for (int tq = 0; tq < 4; ++tq)
#pragma unroll
        for (int r = 0; r < 16; ++r) { p[tq][r] = __builtin_amdgcn_exp2f(p[tq][r] - mx); s += p[tq][r]; }
    s = xhalf_sum(s);
    const float inv = nvalid > 0 ? 1.f / s : 0.f;
#pragma unroll
    for (int tq = 0; tq < 4; ++tq)
#pragma unroll
        for (int r = 0; r < 16; ++r) p[tq][r] *= inv;
    float imp[16];
    {
        float glast[16];
#pragma unroll
        for (int tq = 0; tq < 4; ++tq)
#pragma unroll
            for (int g4 = 0; g4 < 4; ++g4) { imp[4 * tq + g4] = (p[tq][4 * g4] + p[tq][4 * g4 + 1]) + (p[tq][4 * g4 + 2] + p[tq][4 * g4 + 3]); glast[4 * tq + g4] = p[tq][4 * g4 + 3]; }
        float prev = 0.f;
#pragma unroll
        for (int k = 0; k < 16; ++k) { const float pl = xhalf_get(glast[k]); imp[k] += hi ? pl : prev; prev = pl; }
#pragma unroll
        for (int k = 0; k < 16; ++k) { imp[k] += quad_xor1(imp[k]); imp[k] += quad_xor2(imp[k]); }
    }
    LAS float* impl = (LAS float*)(lds + LIMP) + wid * 256;
    if ((r32 & 3) == 0) {
#pragma unroll
        for (int k = 0; k < 16; ++k) impl[(r32 >> 2) * 32 + 2 * k + hi] = imp[k];
    }
    f32x16 o[2]; o[0] = f32x16{}; o[1] = f32x16{};
    const int vboff = ((lane >> 4) & 1) * 32 + (lane & 3) * 8 + (4 * hi + ((lane & 15) >> 2)) * 64;
    pv(o, lds + LV + vboff, p[0], p[1]); pv(o, lds + LV + 8192 + vboff, p[2], p[3]);
    {
        LAS bf16* stg = (LAS bf16*)(lds + LOST) + wid * 2048;
#pragma unroll
        for (int r = 0; r < 16; ++r) { const int orow = crow(r, hi); stg[orow * 64 + r32] = (bf16)f2bf(o[0][r]); stg[orow * 64 + 32 + r32] = (bf16)f2bf(o[1][r]); }
        LDS_WAIT();
#pragma unroll
        for (int i = 0; i < 4; ++i) {
            const int row = i * 8 + (lane >> 3), ch = lane & 7;
            const v4u v = *(const LAS v4u*)(stg + row * 64 + ch * 8);
            *(v4u*)(P.OC() + (rowbase + s0 + 8 * wid + (row >> 2)) * 512 + (4 * g + (row & 3)) * 64 + ch * 8) = v;
        }
    }
    LDS_WAIT();
    {
        const int ti = lane >> 3, jq = lane & 7, tk = s0 + 8 * wid + ti; const int curb = qblk;
        const int nforced = 1 + (curb >= 1) + (curb >= 2);
        unsigned long long keyj[4];
#pragma unroll
        for (int jj = 0; jj < 4; ++jj) { const int jx = 4 * jq + jj; keyj[jj] = ((unsigned long long)__float_as_uint(impl[ti * 32 + jx]) << 5) | (unsigned)(31 - jx); }
        int rank[4] = {0, 0, 0, 0};
        for (int k = 1; k <= curb - 2; ++k) {
            const unsigned long long keyk = ((unsigned long long)__float_as_uint(impl[ti * 32 + k]) << 5) | (unsigned)(31 - k);
#pragma unroll
            for (int jj = 0; jj < 4; ++jj) rank[jj] += keyk > keyj[jj] ? 1 : 0;
        }
        unsigned bits = 0u;
#pragma unroll
        for (int jj = 0; jj < 4; ++jj) {
            const int jx = 4 * jq + jj;
            const bool forced = (jx == 0) || (jx == curb) || (jx == curb - 1);
            const bool valid = jx <= curb;
            const bool sel = forced ? valid : (valid && rank[jj] < 8 - nforced);
            bits |= sel ? (1u << jx) : 0u;
        }
        bits |= __shfl_xor(bits, 1); bits |= __shfl_xor(bits, 2); bits |= __shfl_xor(bits, 4);
        if (jq == 0) P.SELM()[(size_t)(b * 2 + g) * SEQ + tk] = bits;
    }
}
}

namespace att {
constexpr int L2K = 0, L2V = 32768, L2CK = 65536, L2WS = 66560, L2OST = 68608, L2END = 101376;

__device__ __forceinline__ float max3f(float a, float b, float c) { float r; asm("v_max3_f32 %0, %1, %2, %3" : "=v"(r) : "v"(a), "v"(b), "v"(c)); return r; }
#define MAX2(a_, b_) max3f((a_), (b_), (b_))
#define ATT2_SOFTMAX(P0, P1, O_, MREF, L_, C2Q, SM_, QPOS, QBASE) do { \
        const bool diag_ = (kv0 + 63 > (QBASE)) || (MODE == 1 && kv0 <= (QBASE) + 31 - 512); \
        if (diag_) { const bool blk = true; \
            int dq = (QPOS) - kv0 - 4 * hi; asm volatile("" : "+v"(dq));     \
            _Pragma("unroll") for (int r = 0; r < 16; ++r) { const int c_r = (r & 3) + 8 * (r >> 2); bool va = blk && c_r <= dq, vb = blk && c_r + 32 <= dq; \
                if (MODE == 1) { va = va && c_r > dq - 512; vb = vb && c_r + 32 > dq - 512; } P0[r] = va ? P0[r] : -INFINITY; P1[r] = vb ? P1[r] : -INFINITY; } } \
        if (MODE != 0 && !diag_) asm volatile("s_nop 15\n\ts_nop 7" : "+v"(P0), "+v"(P1));     \
        float mxa = max3f(P0[0], P1[0], P0[1]), mxb = max3f(P1[1], P0[2], P1[2]); \
        _Pragma("unroll") for (int r = 3; r < 15; r += 2) { mxa = max3f(mxa, P0[r], P1[r]); mxb = max3f(mxb, P0[r + 1], P1[r + 1]); } \
        float mx = max3f(mxa, mxb, max3f(P0[15], P1[15], P0[15])); \
        { auto rr_ = __builtin_amdgcn_permlane32_swap(__float_as_uint(mx), __float_as_uint(mx), false, false); mx = max3f(__uint_as_float(rr_[0]), __uint_as_float(rr_[1]), __uint_as_float(rr_[1])); } \
        if (__any(mx > 8.f)) { const float dl = MAX2(mx, 0.f), alpha = __builtin_amdgcn_exp2f(-dl); MREF += dl; L_ *= alpha; \
            _Pragma("unroll") for (int r = 0; r < 16; ++r) { P0[r] -= dl; P1[r] -= dl; } \
            if (hi == 0) wsf[r32] = alpha; LDS_WAIT(); \
            _Pragma("unroll") for (int g4 = 0; g4 < 4; ++g4) { const f32x4 a = *(const LAS f32x4*)(wsf + 8 * g4 + 4 * hi); \
                _Pragma("unroll") for (int j = 0; j < 4; ++j) { O_[0][4 * g4 + j] *= a[j]; O_[1][4 * g4 + j] *= a[j]; } } \
            LDS_WAIT(); } \
        float s0 = 0.f, s1 = 0.f, s2 = 0.f, s3 = 0.f; \
        _Pragma("unroll") for (int r = 0; r < 16; r += 2) { P0[r] = __builtin_amdgcn_exp2f(P0[r]); P1[r] = __builtin_amdgcn_exp2f(P1[r]); P0[r + 1] = __builtin_amdgcn_exp2f(P0[r + 1]); P1[r + 1] = __builtin_amdgcn_exp2f(P1[r + 1]); \
            s0 += P0[r]; s1 += P1[r]; s2 += P0[r + 1]; s3 += P1[r + 1]; } \
        L_ += (s0 + s1) + (s2 + s3); } while (0)

template <int MODE>
__device__ __forceinline__ void attn_unit2(int b, int hp, int qb, const Ptrs& P, LAS char* lds) {
    int tid = threadIdx.x; asm volatile("" : "+v"(tid));
    const int lane = tid & 63, r32 = lane & 31, hi = lane >> 5; const int wid = __builtin_amdgcn_readfirstlane(tid >> 6), sub = wid >> 2, w4 = wid & 3;
    const int h = 2 * hp + sub;
    const size_t rowbase = (size_t)b * SEQ; const int q0 = qb * 256, qw0 = q0 + w4 * 64, qposA = qw0 + r32, qposB = qposA + 32;
    const bf16* Qp = (MODE == 0) ? P.F3() + (rowbase * 512 + h * 64) : P.Qr() + (rowbase * 512 + h * 64);
    bf16x8 qrA[4], qrB[4];
#pragma unroll
    for (int d0 = 0; d0 < 4; ++d0) { qrA[d0] = *(const bf16x8*)(Qp + (size_t)qposA * 512 + d0 * 16 + hi * 8); qrB[d0] = *(const bf16x8*)(Qp + (size_t)qposB * 512 + d0 * 16 + hi * 8); }
    float c2qA = 0.f, c2qB = 0.f; unsigned smA = 0u, smB = 0u; const float* c2p = nullptr;
    if (MODE == 0) { c2p = P.C2() + (size_t)(b * 8 + h) * SEQ; c2qA = c2p[qposA]; c2qB = c2p[qposB]; }
    if (MODE == 2) { const unsigned* sp = P.SELM() + (size_t)(b * 2 + (hp >> 1)) * SEQ; smA = sp[qposA]; smB = sp[qposB]; }
    asm volatile("" : "+v"(qrA[0]), "+v"(qrA[1]), "+v"(qrA[2]), "+v"(qrA[3]), "+v"(qrB[0]), "+v"(qrB[1]), "+v"(qrB[2]), "+v"(qrB[3]), "+v"(c2qA), "+v"(c2qB), "+v"(smA), "+v"(smB));
    int t0 = (MODE == 1) ? (4 * qb - 8 > 0 ? 4 * qb - 8 : 0) : 0; const int t1 = 4 * qb + 4;
    float prune_c = 0.f;
    if (MODE == 0) {
        int first2 = 64;
#pragma unroll
        for (int s_ = 0; s_ < 2; ++s_) { const int hh_ = 2 * hp + s_; const float* cp = P.C2() + (size_t)(b * 8 + hh_) * SEQ;
            const float smax = sqrtf(P.SN()[b * 8 + hh_] * P.SN()[128 + b * 8 + hh_]);
            const unsigned long long keep = __ballot(cp[q0] - cp[64 * r32 + 63] + 2.f * smax >= -50.f);
            const int first = keep ? (int)__builtin_ctzll(keep) : 0; first2 = first < first2 ? first : first2;
            if (s_ == sub) prune_c = 2.f * smax + 50.f + cp[qw0]; }
        t0 = __builtin_amdgcn_readfirstlane(first2 < 4 * qb ? first2 : 4 * qb);
    }
    const bf16 *kbase, *vbase; int kvp, np, pk0, sslot;
    if (MODE == 0) { const int hs = 2 * hp + sub; kbase = P.F3() + (size_t)T * 512 + (rowbase * 512 + hs * 64); vbase = P.F3() + (size_t)2 * T * 512 + (rowbase * 512 + hs * 64); kvp = 512; np = 2; sslot = sub; pk0 = w4; }
    else { const int g = hp >> 1; const int ti = (MODE == 1) ? 4 : 2; kbase = P.KV6() + (size_t)ti * T * 128 + (rowbase * 128 + g * 64); vbase = P.KV6() + (size_t)(ti + 1) * T * 128 + (rowbase * 128 + g * 64); kvp = 128; np = 1; sslot = 0; pk0 = wid; }
    const bf16* ksrc = kbase + (size_t)lane * kvp + pk0 * 8; const bf16* vsrc = vbase + (size_t)(16 * (pk0 & 3) + (lane >> 2)) * kvp + (pk0 >> 2) * 32 + (lane & 3) * 8;
    const int sbase = sslot * 8192 + pk0 * 1024;
    const int myslot = (MODE == 0) ? sub : 0;
#define ATT2_DMA(T_, ST_) do { _Pragma("unroll") for (int i = 0; i < 2; ++i) if (i < np) { \
            __builtin_amdgcn_global_load_lds((const unsigned*)(ksrc + (size_t)(T_) * 64 * kvp + 32 * i), (LAS unsigned*)(lds + L2K + (ST_) * 16384 + sbase + 4096 * i), 16, 0, 0); \
            __builtin_amdgcn_global_load_lds((const unsigned*)(vsrc + (size_t)(T_) * 64 * kvp + 32 * i), (LAS unsigned*)(lds + L2V + (ST_) * 16384 + sbase + 4096 * i), 16, 0, 0); } \
        if (MODE == 0 && wid < 2) __builtin_amdgcn_global_load_lds((const unsigned*)(P.C2() + (size_t)(b * 8 + 2 * hp + wid) * SEQ + (T_) * 64 + lane), (LAS unsigned*)(lds + L2CK + (ST_) * 512 + wid * 256), 4, 0, 0); } while (0)
#define ATT2_LANDED() do { asm volatile("s_waitcnt vmcnt(0)" ::: "memory"); __syncthreads(); } while (0)
    __syncthreads();
    ATT2_DMA(t0, 0);
    ATT2_LANDED();
    float mrefA = 0.f, lA = 0.f, mrefB = 0.f, lB = 0.f; f32x16 oA[2], oB[2]; oA[0] = f32x16{}; oA[1] = f32x16{}; oB[0] = f32x16{}; oB[1] = f32x16{};
    LAS float* wsf = (LAS float*)(lds + L2WS) + wid * 64;
    const int vboff = ((lane >> 4) & 1) * 32 + (lane & 3) * 8 + (4 * hi + ((lane & 15) >> 2)) * 64;
    for (int t = t0; t < t1; ++t) {
        const int cur = (t - t0) & 1;
        if (t + 1 < t1) ATT2_DMA(t + 1, cur ^ 1);
        const int kv0 = t * 64;
        const LAS float* ck = (const LAS float*)(lds + L2CK + cur * 512 + myslot * 256);
        bool active = kv0 <= qw0 + 63;
        if (MODE == 1) active = active && (kv0 + 63 > qw0 - 512);
        if (MODE == 0) active = active && (__builtin_amdgcn_readfirstlane(__float_as_uint(prune_c - ck[63])) >> 31) == 0u;
        if (active) {
            const LAS char* kb = lds + L2K + cur * 16384 + myslot * 8192 + hi * 1024 + r32 * 16;
            f32x16 pa0, pa1, pb0, pb1;
            const float iniA = (MODE == 2 && ((smA >> t) & 1u) == 0u) ? -INFINITY : (MODE == 0 ? c2qA - mrefA : -mrefA), iniB = (MODE == 2 && ((smB >> t) & 1u) == 0u) ? -INFINITY : (MODE == 0 ? c2qB - mrefB : -mrefB);
#pragma unroll
            for (int r = 0; r < 16; ++r) { pa0[r] = iniA; pa1[r] = iniA; pb0[r] = iniB; pb1[r] = iniB; }
#pragma unroll
            for (int d0 = 0; d0 < 4; ++d0) {
                const bf16x8 k0 = *(const LAS bf16x8*)(kb + d0 * 2048), k1 = *(const LAS bf16x8*)(kb + d0 * 2048 + 512);
                pa0 = __builtin_amdgcn_mfma_f32_32x32x16_bf16(k0, qrA[d0], pa0, 0, 0, 0); pa1 = __builtin_amdgcn_mfma_f32_32x32x16_bf16(k1, qrA[d0], pa1, 0, 0, 0);
                pb0 = __builtin_amdgcn_mfma_f32_32x32x16_bf16(k0, qrB[d0], pb0, 0, 0, 0); pb1 = __builtin_amdgcn_mfma_f32_32x32x16_bf16(k1, qrB[d0], pb1, 0, 0, 0);
            }
            if (MODE == 0) {
#pragma unroll
                for (int g4 = 0; g4 < 4; ++g4) { const f32x4 a = *(const LAS f32x4*)(ck + 8 * g4 + 4 * hi), bb = *(const LAS f32x4*)(ck + 32 + 8 * g4 + 4 * hi);
#pragma unroll
                    for (int j = 0; j < 4; ++j) { pa0[4 * g4 + j] -= a[j]; pa1[4 * g4 + j] -= bb[j]; pb0[4 * g4 + j] -= a[j]; pb1[4 * g4 + j] -= bb[j]; }
                    asm volatile("" ::: "memory"); }
            }
            ATT2_SOFTMAX(pa0, pa1, oA, mrefA, lA, c2qA, smA, qposA, qw0);
            ATT2_SOFTMAX(pb0, pb1, oB, mrefB, lB, c2qB, smB, qposB, qw0 + 32);
            v4u pwA[4], pwB[4];
#pragma unroll
            for (int i = 0; i < 4; ++i) { pwA[0][i] = pk2(pa0[2 * i], pa0[2 * i + 1]); pwA[1][i] = pk2(pa0[8 + 2 * i], pa0[9 + 2 * i]); pwA[2][i] = pk2(pa1[2 * i], pa1[2 * i + 1]); pwA[3][i] = pk2(pa1[8 + 2 * i], pa1[9 + 2 * i]);
                                          pwB[0][i] = pk2(pb0[2 * i], pb0[2 * i + 1]); pwB[1][i] = pk2(pb0[8 + 2 * i], pb0[9 + 2 * i]); pwB[2][i] = pk2(pb1[2 * i], pb1[2 * i + 1]); pwB[3][i] = pk2(pb1[8 + 2 * i], pb1[9 + 2 * i]); }
            const LAS char* vb = lds + L2V + cur * 16384 + myslot * 8192 + vboff;
#pragma unroll
            for (int d0 = 0; d0 < 2; ++d0)
#pragma unroll
                for (int ks = 0; ks < 4; ++ks) {
                    const s16x4 lo = vtr(vb + d0 * 4096 + ks * 1024), hh = vtr(vb + d0 * 4096 + ks * 1024 + 512);
                    const bf16x8 vf = (bf16x8){lo[0], lo[1], lo[2], lo[3], hh[0], hh[1], hh[2], hh[3]};
                    oA[d0] = __builtin_amdgcn_mfma_f32_32x32x16_bf16(__builtin_bit_cast(bf16x8, pwA[ks]), vf, oA[d0], 0, 0, 0);
                    oB[d0] = __builtin_amdgcn_mfma_f32_32x32x16_bf16(__builtin_bit_cast(bf16x8, pwB[ks]), vf, oB[d0], 0, 0, 0);
                }
        }
        ATT2_LANDED();
    }
#undef ATT2_DMA
#undef ATT2_LANDED
#pragma unroll
    for (int blk2 = 0; blk2 < 2; ++blk2) {
        const f32x16* o = blk2 ? oB : oA; const float l_part = blk2 ? lB : lA;
        const float l = xhalf_sum(l_part);
        if (hi == 0) wsf[32 + r32] = l;
        LDS_WAIT();
        LAS bf16* stg = (LAS bf16*)(lds + L2OST) + wid * 2048;
#pragma unroll
        for (int r = 0; r < 16; ++r) {
            const float lr = wsf[32 + crow(r, hi)]; const float inv = lr > 0.f ? __builtin_amdgcn_rcpf(lr) : 0.f; const int orow = crow(r, hi);
            stg[orow * 64 + r32] = (bf16)f2bf(o[0][r] * inv); stg[orow * 64 + 32 + r32] = (bf16)f2bf(o[1][r] * inv);
        }
        LDS_WAIT();
#pragma unroll
        for (int i = 0; i < 4; ++i) {
            const int row = i * 8 + (lane >> 3), ch = lane & 7; const size_t grow = rowbase + qw0 + blk2 * 32 + row;
            const v4u v = *(const LAS v4u*)(stg + row * 64 + ch * 8);
            if (MODE == 0) *(v4u*)(P.AO() + grow * 1024 + 512 + h * 64 + ch * 8) = v;
            else if (MODE == 1) *(v4u*)(P.OW() + grow * 512 + h * 64 + ch * 8) = v;
            else {
                const float g0 = P.SG()[grow * 32 + h * 3 + 0], g1 = P.SG()[grow * 32 + h * 3 + 1], g2 = P.SG()[grow * 32 + h * 3 + 2];
                const v4u vc = *(const v4u*)(P.OC() + grow * 512 + h * 64 + ch * 8), vw = *(const v4u*)(P.OW() + grow * 512 + h * 64 + ch * 8);
                v4u out;
#pragma unroll
                for (int j = 0; j < 4; ++j) {
                    const float lo = g0 * bf_lo(vc[j]) + g1 * bf_lo(v[j]) + g2 * bf_lo(vw[j]);
                    const float hh = g0 * bf_hi(vc[j]) + g1 * bf_hi(v[j]) + g2 * bf_hi(vw[j]);
                    out[j] = pk2(lo, hh);
                }
                *(v4u*)(P.AO() + grow * 1024 + h * 64 + ch * 8) = out;
            }
        }
        LDS_WAIT();
    }
}
#undef ATT2_SOFTMAX
#undef MAX2
}

#ifndef MOE_ALIGN
#define MOE_ALIGN true
#endif

struct Args { const void* in[19]; float* out; unsigned char* ws; int ph_lo, ph_hi, rep_mask, pad; };
struct Frame {
    LAS unsigned char* lds; volatile LAS unsigned* MISC; gu32* ctl;
    int tid, lane, wave, vcu, G;
    unsigned char* ws;
};

template <class Map>
__device__ __forceinline__ void transpose_item(const float* W, int Nsrc, bf16* WT, int ldt, int koff, int k0, int n0, const Map& map4, LAS float* scr, int lane) {
    const int c = lane & 15, sc = map4(n0 + 4 * c);
    f32x4 v[16];
#pragma unroll
    for (int i = 0; i < 16; ++i) { const int kk = (lane >> 4) + 4 * i; v[i] = sc >= 0 ? *(const f32x4*)(W + (size_t)(k0 + kk) * Nsrc + sc) : (f32x4){0.f, 0.f, 0.f, 0.f}; }
#pragma unroll
    for (int i = 0; i < 16; ++i) { const int kk = (lane >> 4) + 4 * i;
#pragma unroll
        for (int j = 0; j < 4; ++j) scr[(4 * c + j) * 65 + kk] = v[i][j]; }
    LDS_WAIT(); asm volatile("" ::: "memory");
    const int ch = lane & 7;
#pragma unroll
    for (int jj = 0; jj < 8; ++jj) { const int n = (lane >> 3) + 8 * jj; const LAS float* s = scr + n * 65 + 8 * ch;
        v4u o; o.x = pk2(s[0], s[1]); o.y = pk2(s[2], s[3]); o.z = pk2(s[4], s[5]); o.w = pk2(s[6], s[7]);
        *(v4u*)(WT + (size_t)(n0 + n) * ldt + koff + k0 + 8 * ch) = o; }
    LDS_WAIT(); asm volatile("" ::: "memory");
}
template <class Map>
__device__ __forceinline__ void transpose_item_f8(const float* W, int Nsrc, unsigned char* WT8, int ldt, int koff, int k0, int n0, const Map& map4, LAS float* scr, int lane) {
    const int c = lane & 7, r = lane >> 3, sc = map4(n0 + 4 * c);
    f32x4 v[16];
#pragma unroll
    for (int i = 0; i < 16; ++i) v[i] = sc >= 0 ? __builtin_nontemporal_load((const f32x4*)(W + (size_t)(k0 + 16 * r + i) * Nsrc + sc)) : (f32x4){0.f, 0.f, 0.f, 0.f};
#pragma unroll
    for (int j = 0; j < 4; ++j) {
        v4u o;
        o.x = pk4f8(64.f * v[0][j], 64.f * v[1][j], 64.f * v[2][j], 64.f * v[3][j]);     o.y = pk4f8(64.f * v[4][j], 64.f * v[5][j], 64.f * v[6][j], 64.f * v[7][j]);
        o.z = pk4f8(64.f * v[8][j], 64.f * v[9][j], 64.f * v[10][j], 64.f * v[11][j]);   o.w = pk4f8(64.f * v[12][j], 64.f * v[13][j], 64.f * v[14][j], 64.f * v[15][j]);
        *(v4u*)(WT8 + (size_t)(n0 + 4 * c + j) * ldt + koff + k0 + 16 * r) = o;
    }
}
struct MapId { __device__ __forceinline__ int operator()(int n) const { return n; } };
struct MapIn { __device__ __forceinline__ int operator()(int n) const { return n < 1280 ? n : n < 2816 ? n + 24 : n < 4864 ? n + 32 : n < 4888 ? 1280 + (n - 4864) : n < 4896 ? 2840 + (n - 4888) : -1; } };
struct MapW1 { __device__ __forceinline__ int operator()(int n) const { const int t = n >> 8, i = n & 255; return i < 128 ? 128 * t + i : 1024 + 128 * t + (i - 128); } };

constexpr int CONV_I1 = 8 * 64, CONV_I2 = 8 * 32, CONV_ITEMS = 32 * (CONV_I1 + CONV_I2);
__device__ __forceinline__ void expert_item(Frame& F, const Args& a, int r) {
    const float* ew1 = (const float*)a.in[14]; const float* ew2 = (const float*)a.in[16];
    unsigned char* W1 = F.ws + WS_W1; unsigned char* W2 = F.ws + WS_W2;
    LAS float* scr = (LAS float*)(F.lds + F.wave * 16640);
    if (r < 32 * CONV_I1) { const int e = r / CONV_I1, q = r % CONV_I1, kb = q / 64, nb = q % 64; transpose_item_f8(ew1 + (size_t)e * 1024 * 2048, 2048, W1 + (size_t)e * 2048 * 1024, 1024, 0, 128 * kb, 32 * nb, MapW1(), scr, F.lane); return; }
    r -= 32 * CONV_I1;
    { const int e = r / CONV_I2, q = r % CONV_I2, kb = q / 32, nb = q % 32; transpose_item_f8(ew2 + (size_t)e * 1024 * 1024, 1024, W2 + (size_t)e * 1024 * 1024, 1024, 0, 128 * kb, 32 * nb, MapId(), scr, F.lane); }
}
__device__ __forceinline__ void conv_pair(Frame& F, const Args& a, int r0, int r1) {
    const float* ew1 = (const float*)a.in[14]; const float* ew2 = (const float*)a.in[16];
    const float* Wp[2]; unsigned char* Op[2]; int ns[2], k0[2], sc[2]; const int c = F.lane & 7, rr = F.lane >> 3;
#pragma unroll
    for (int q_ = 0; q_ < 2; ++q_) { int r = q_ ? r1 : r0; if (r >= CONV_ITEMS) r = CONV_ITEMS - 1;
        if (r < 32 * CONV_I1) { const int e = r / CONV_I1, q = r % CONV_I1, kb = q / 64, nb = q % 64; Wp[q_] = ew1 + (size_t)e * 1024 * 2048; ns[q_] = 2048; k0[q_] = 128 * kb; sc[q_] = MapW1()(32 * nb + 4 * c);
            Op[q_] = F.ws + WS_W1 + (size_t)e * 2048 * 1024 + (size_t)(32 * nb + 4 * c) * 1024 + 128 * kb + 16 * rr; }
        else { r -= 32 * CONV_I1; const int e = r / CONV_I2, q = r % CONV_I2, kb = q / 32, nb = q % 32; Wp[q_] = ew2 + (size_t)e * 1024 * 1024; ns[q_] = 1024; k0[q_] = 128 * kb; sc[q_] = 32 * nb + 4 * c;
            Op[q_] = F.ws + WS_W2 + (size_t)e * 1024 * 1024 + (size_t)(32 * nb + 4 * c) * 1024 + 128 * kb + 16 * rr; } }
    f32x4 va[16], vb[16];
#pragma unroll
    for (int i = 0; i < 16; ++i) va[i] = __builtin_nontemporal_load((const f32x4*)(Wp[0] + (size_t)(k0[0] + 16 * rr + i) * ns[0] + sc[0]));
#pragma unroll
    for (int i = 0; i < 16; ++i) vb[i] = __builtin_nontemporal_load((const f32x4*)(Wp[1] + (size_t)(k0[1] + 16 * rr + i) * ns[1] + sc[1]));
#pragma unroll
    for (int q_ = 0; q_ < 2; ++q_) {
        if (q_ == 1 && r1 >= CONV_ITEMS) break;
#pragma unroll
        for (int j = 0; j < 4; ++j) { v4u o;
#define CV_(i_) (64.f * (q_ ? vb[i_][j] : va[i_][j]))
            o.x = pk4f8(CV_(0), CV_(1), CV_(2), CV_(3)); o.y = pk4f8(CV_(4), CV_(5), CV_(6), CV_(7)); o.z = pk4f8(CV_(8), CV_(9), CV_(10), CV_(11)); o.w = pk4f8(CV_(12), CV_(13), CV_(14), CV_(15));
#undef CV_
            *(v4u*)(Op[q_] + (size_t)j * 1024) = o; }
    }
}
__device__ __forceinline__ void conv_drain(Frame& F, const Args& a, int watch_cw, int watch_n) {
    LAS int* qslot = (LAS int*)(F.lds + LDSCTL_OFF);
    __syncthreads();
    if (F.tid == 0) qslot[0] = (int)__hip_atomic_fetch_add((unsigned*)(F.ctl + CW_QC), 1u, RLX_AGENT);
    __syncthreads();
    int bt = qslot[0];
    while (bt * 16 < CONV_ITEMS) {
        int nx = 0, w = -1;
        if (F.tid == 0) { nx = (int)__hip_atomic_fetch_add((unsigned*)(F.ctl + CW_QC), 1u, RLX_AGENT); if (watch_cw >= 0) w = (int)__hip_atomic_load((unsigned*)(F.ctl + watch_cw), RLX_AGENT); }
        conv_pair(F, a, bt * 16 + F.wave * 2, bt * 16 + F.wave * 2 + 1);
        __syncthreads();
        if (F.tid == 0) { qslot[0] = nx; qslot[1] = (watch_cw >= 0 && w >= watch_n) ? 1 : 0; }
        __syncthreads();
        const int stop = qslot[1]; bt = qslot[0];
        if (stop) { if (bt * 16 < CONV_ITEMS) conv_pair(F, a, bt * 16 + F.wave * 2, bt * 16 + F.wave * 2 + 1); break; }
    }
    __syncthreads();
}
__device__ __forceinline__ void conv_one(Frame& F, const Args& a) {
    LAS int* qslot = (LAS int*)(F.lds + LDSCTL_OFF);
    __syncthreads();
    if (F.tid == 0) qslot[1] = (int)__hip_atomic_fetch_add((unsigned*)(F.ctl + CW_QC), 1u, RLX_AGENT);
    __syncthreads();
    const int it = qslot[1] * 16 + F.wave * 2;
    if (it < CONV_ITEMS) conv_pair(F, a, it, it + 1);
}
__device__ __forceinline__ void p0_prologue(Frame& F, const Args& a) {
    const float* x = (const float*)a.in[0]; const int* pos = (const int*)a.in[1]; const float* g1 = (const float*)a.in[2]; const float* w_in = (const float*)a.in[3];
    const float* pe = (const float*)a.in[4]; const float* cw1 = (const float*)a.in[5];
    const float* wpn = (const float*)a.in[8]; const float* wpf = (const float*)a.in[9]; const float* wout = (const float*)a.in[10];
    const float* ew1 = (const float*)a.in[14]; const float* ew2 = (const float*)a.in[16];
    LAS float* scr = (LAS float*)(F.lds + F.wave * 16640);
    const int gw = F.vcu * NWAVES + F.wave, NGW = F.G * NWAVES;
    constexpr int I_IN = 8 * 160, I_P = 8 * 16, I_O = 16 * 16, I_1 = 8 * 64, I_2 = 8 * 32, I_C = 32;
    constexpr int NITEMS = I_IN + 2 * I_P + I_O + 32 * I_1 + 32 * I_2 + 2 * I_C;
    unsigned char* Win8 = F.ws + WS_WIN; bf16* Wp = (bf16*)(F.ws + WS_WP); bf16* Wo = (bf16*)(F.ws + WS_WOUT); unsigned char* W1 = F.ws + WS_W1; unsigned char* W2 = F.ws + WS_W2; bf16* W1c = (bf16*)(F.ws + WS_W1C);
#ifndef CONV_MOD
#define CONV_MOD 8
#endif
    for (int it = gw; it < NITEMS; it += NGW) {
        int r = it;
        if (CONV_MOD != 0 && r >= I_IN + 2 * I_P + I_O && r < I_IN + 2 * I_P + I_O + 32 * I_1 + 32 * I_2) continue;
        if (r < I_IN) { const int kb = r / 160, nb = r % 160; transpose_item_f8(w_in, IN_COLS, Win8, 1024, 0, 128 * kb, 32 * nb, MapIn(), scr, F.lane); continue; } r -= I_IN;
        if (r < I_P) { const int kb = r / 16, nb = r % 16; transpose_item(wpn, 1024, Wp, 1024, 0, 64 * kb, 64 * nb, MapId(), scr, F.lane); continue; } r -= I_P;
        if (r < I_P) { const int kb = r / 16, nb = r % 16; transpose_item(wpf, 1024, Wp, 1024, 512, 64 * kb, 64 * nb, MapId(), scr, F.lane); continue; } r -= I_P;
        if (r < I_O) { const int kb = r / 16, nb = r % 16; transpose_item(wout, 1024, Wo, 1024, 0, 64 * kb, 64 * nb, MapId(), scr, F.lane); continue; } r -= I_O;
        if (r < 32 * I_1) { const int e = r / I_1, q = r % I_1, kb = q / 64, nb = q % 64; transpose_item_f8(ew1 + (size_t)e * 1024 * 2048, 2048, W1 + (size_t)e * 2048 * 1024, 1024, 0, 128 * kb, 32 * nb, MapW1(), scr, F.lane); continue; } r -= 32 * I_1;
        if (r < 32 * I_2) { const int e = r / I_2, q = r % I_2, kb = q / 32, nb = q % 32; transpose_item_f8(ew2 + (size_t)e * 1024 * 1024, 1024, W2 + (size_t)e * 1024 * 1024, 1024, 0, 128 * kb, 32 * nb, MapId(), scr, F.lane); continue; } r -= 32 * I_2;
        { const int ts = r / I_C, kb = r % I_C; transpose_item(cw1 + (size_t)ts * 2048 * 64, 64, W1c + (size_t)ts * 64 * 2048, 2048, 0, 64 * kb, 0, MapId(), scr, F.lane); }
    }
    unsigned char* H8 = F.ws + WS_H;
    {
        f32x4 gv[4];
#pragma unroll
        for (int j = 0; j < 4; ++j) gv[j] = *((const f32x4*)g1 + F.lane + 64 * j);
        for (int m = gw; m < T; m += 2 * NGW) {
            const f32x4* xr0 = (const f32x4*)(x + (size_t)m * 1024) + F.lane; const f32x4* xr1 = (const f32x4*)(x + (size_t)(m + NGW) * 1024) + F.lane;
            f32x4 v[2][4]; float s0 = 0.f, s1 = 0.f;
#pragma unroll
            for (int j = 0; j < 4; ++j) { v[0][j] = xr0[64 * j]; v[1][j] = xr1[64 * j]; }
#pragma unroll
            for (int j = 0; j < 4; ++j) { s0 += (v[0][j].x * v[0][j].x + v[0][j].y * v[0][j].y) + (v[0][j].z * v[0][j].z + v[0][j].w * v[0][j].w);
                                          s1 += (v[1][j].x * v[1][j].x + v[1][j].y * v[1][j].y) + (v[1][j].z * v[1][j].z + v[1][j].w * v[1][j].w); }
            const float rs0 = 1.0f / sqrtf(wave_sum(s0) * (1.f / 1024.f) + NORM_EPS), rs1 = 1.0f / sqrtf(wave_sum(s1) * (1.f / 1024.f) + NORM_EPS);
            unsigned* o0 = (unsigned*)(H8 + (size_t)m * 1024) + F.lane; unsigned* o1 = (unsigned*)(H8 + (size_t)(m + NGW) * 1024) + F.lane;
#pragma unroll
            for (int j = 0; j < 4; ++j) { const f32x4 y0 = v[0][j] * (16.f * rs0) * gv[j], y1 = v[1][j] * (16.f * rs1) * gv[j];
                o0[64 * j] = pk4f8(y0.x, y0.y, y0.z, y0.w); o1[64 * j] = pk4f8(y1.x, y1.y, y1.z, y1.w); }
        }
    }
    {
        float* CS = (float*)(F.ws + WS_CS);
        for (int idx = (F.vcu * 512 + F.tid); idx < T * 8; idx += F.G * 512) {
            const int t = idx >> 3, i = idx & 7;
            const float freq = exp2f(-(float)i * 0.125f * 18.931568569324174f);
            const float ang = (float)pos[t] * freq;
            const float kq = rintf(ang * 0.15915494309189535f);
            float rem = fmaf(-kq, 6.28318548202514648f, ang); rem = fmaf(-kq, -1.74845553e-7f, rem);
            const float rev = rem * 0.15915494309189535f;
            CS[(size_t)t * 16 + i] = __builtin_amdgcn_cosf(rev); CS[(size_t)t * 16 + 8 + i] = __builtin_amdgcn_sinf(rev);
        }
    }
    {
        const float* g2 = (const float*)a.in[11]; const float* rw = (const float*)a.in[12]; unsigned* WB = (unsigned*)(F.ws + WS_WRB);
        for (int idx = F.vcu * 512 + F.tid; idx < 16384; idx += F.G * 512) {
            const int e = idx & 31, dp = idx >> 5;
            const float w0 = rw[(2 * dp) * 32 + e] * g2[2 * dp], w1 = rw[(2 * dp + 1) * 32 + e] * g2[2 * dp + 1];
            const unsigned ph = pk2(w0, w1); const unsigned pl = pk2(w0 - bf_lo(ph), w1 - bf_hi(ph));
            WB[e * 516 + dp] = ph; WB[16512 + e * 516 + dp] = pl;
        }
    }
    if (gw < 128) {
        const int ts = gw >> 6, n = gw & 63; float s = 0.f;
        for (int k = F.lane; k < 2048; k += 64) s += pe[(size_t)ts * 2048 + k] * cw1[((size_t)ts * 2048 + k) * 64 + n];
        s = wave_sum(s);
        if (F.lane == 0) ((float*)(F.ws + WS_CCONST))[gw] = s;
    }
}

__device__ __forceinline__ float gelu_tanh(float x) { const float u = 0.7978845608028654f * (x + 0.044715f * x * x * x); const float e = __builtin_amdgcn_exp2f(2.f * LOG2E * u); const float th = 1.f - 2.f * __builtin_amdgcn_rcpf(e + 1.f); return 0.5f * x * (1.f + th); }
__device__ __forceinline__ void p2_compress(Frame& F, const Args& a) {
    const float* cw2 = (const float*)a.in[6];
    const bf16* KV6 = (const bf16*)(F.ws + WS_KV6); const bf16* W1c = (const bf16*)(F.ws + WS_W1C); const float* cconst = (const float*)(F.ws + WS_CCONST);
    const int lane = F.lane, r32 = lane & 31, hi = lane >> 5, wave = F.wave;
    LAS float* red = (LAS float*)F.lds;
    LAS float* gb = (LAS float*)(F.lds + 65536);
    LAS float* w2s = (LAS float*)(F.lds + 65536 + 8192);
    for (int u = F.vcu; u < 256; u += F.G) {
        const int ts = u >> 7, b = (u >> 3) & 15, g = (u >> 2) & 1, cb = u & 3;
        const bf16* src = KV6 + (size_t)ts * T * 128; const bf16* Wt = W1c + (size_t)ts * 64 * 2048;
        const int c = 32 * cb + r32, cl = c < 126 ? c : 126;
        f32x16 a0 = f32x16{}, a1 = f32x16{};
#pragma unroll 4
        for (int k8 = 0; k8 < 16; ++k8) {
            const int ks = 16 * wave + k8, li = ks >> 2, d = 16 * (ks & 3) + 8 * hi;
            const bf16x8 af = *(const bf16x8*)(src + ((size_t)b * SEQ + 16 * cl + li) * 128 + g * 64 + d);
            const bf16x8 b0 = *(const bf16x8*)(Wt + (size_t)r32 * 2048 + 16 * ks + 8 * hi);
            const bf16x8 b1 = *(const bf16x8*)(Wt + (size_t)(r32 + 32) * 2048 + 16 * ks + 8 * hi);
            a0 = __builtin_amdgcn_mfma_f32_32x32x16_bf16(af, b0, a0, 0, 0, 0);
            a1 = __builtin_amdgcn_mfma_f32_32x32x16_bf16(af, b1, a1, 0, 0, 0);
        }
        __syncthreads();
        { const f32x4* w2g = (const f32x4*)(cw2 + (size_t)ts * 4096); ((LAS f32x4*)w2s)[F.tid] = w2g[F.tid]; ((LAS f32x4*)w2s)[F.tid + 512] = w2g[F.tid + 512]; }
#pragma unroll
        for (int r = 0; r < 16; ++r) { const int row = att::crow(r, hi); red[wave * 2048 + row * 64 + r32] = a0[r]; red[wave * 2048 + row * 64 + 32 + r32] = a1[r]; }
        __syncthreads();
#pragma unroll
        for (int q = 0; q < 4; ++q) { const int o = F.tid * 4 + q; float s = cconst[ts * 64 + (o & 63)];
#pragma unroll
            for (int w = 0; w < 8; ++w) s += red[w * 2048 + o];
            gb[o] = gelu_tanh(s); }
        __syncthreads();
        bf16* outp = (bf16*)(F.ws + (ts ? WS_VCMP : WS_KCMP)) + (size_t)(b * 2 + g) * 128 * 64;
        {
            const int row = F.tid >> 4, c4 = (F.tid & 15) * 4; f32x4 acc4 = (f32x4){0.f, 0.f, 0.f, 0.f};
#pragma unroll 8
            for (int n = 0; n < 64; ++n) { const float gv_ = gb[row * 64 + n]; const f32x4 w = *(const LAS f32x4*)(w2s + n * 64 + c4); acc4 += gv_ * w; }
            const int cc = 32 * cb + row;
            v2u w8; w8.x = cc < 127 ? pk2(acc4[0], acc4[1]) : 0u; w8.y = cc < 127 ? pk2(acc4[2], acc4[3]) : 0u;
            *(v2u*)(outp + (size_t)cc * 64 + c4) = w8;
        }
    }
    for (int task = F.vcu; task < 256; task += F.G) {
        const int which = task >> 7, bh = task & 127, b = bh >> 3, h = bh & 7;
        const bf16* src = (const bf16*)(F.ws + WS_F3) + (size_t)which * T * 512 + (size_t)b * SEQ * 512 + h * 64;
        float mx = 0.f;
#pragma unroll
        for (int i = 0; i < 4; ++i) { const int row = F.tid + 512 * i; float n2 = 0.f;
#pragma unroll
            for (int c8 = 0; c8 < 8; ++c8) { const v4u w = *(const v4u*)(src + (size_t)row * 512 + c8 * 8);
#pragma unroll
                for (int j = 0; j < 4; ++j) { const float lo = bf_lo(w[j]), hh = bf_hi(w[j]); n2 += lo * lo + hh * hh; } }
            mx = fmaxf(mx, n2); }
#pragma unroll
        for (int o = 1; o < 64; o <<= 1) mx = fmaxf(mx, __shfl_xor(mx, o));
        __syncthreads();
        if (lane == 0) red[wave] = mx;
        __syncthreads();
        if (F.tid == 0) { float r = red[0]; for (int w = 1; w < 8; ++w) r = fmaxf(r, red[w]); ((float*)(F.ws + WS_SN))[task] = r; }
    }
    for (int task = F.vcu; task < 128; task += F.G) {
        const int b = task >> 3, h = task & 7; const float* SG = (const float*)(F.ws + WS_SG); float* C2 = (float*)(F.ws + WS_C2) + (size_t)task * SEQ;
        float v[4]; float run = 0.f;
#pragma unroll
        for (int i = 0; i < 4; ++i) { run += SG[((size_t)b * SEQ + 4 * F.tid + i) * 32 + 24 + h]; v[i] = run; }
        float incl = run;
#pragma unroll
        for (int o = 1; o < 64; o <<= 1) { const float t = __shfl_up(incl, o); if (lane >= o) incl += t; }
        __syncthreads();
        if (lane == 63) red[wave] = incl;
        __syncthreads();
        float base = incl - run;
        for (int w = 0; w < wave; ++w) base += red[w];
        *(f32x4*)(C2 + 4 * F.tid) = (f32x4){v[0] + base, v[1] + base, v[2] + base, v[3] + base};
    }
}

constexpr int P7_WBROW = 2064, P7_WBHALF = 32 * P7_WBROW, P7_G2S = 2 * P7_WBHALF, P7_LG = P7_G2S + 4096, P7_HIST = P7_LG + 8 * 2112;
__device__ __forceinline__ void p7_route(Frame& F, const Args& a, int nrep) {
    const float* g2 = (const float*)a.in[11]; const float* rb = (const float*)a.in[13];
    const bf16* X1 = (const bf16*)(F.ws + WS_X1); unsigned char* H2 = F.ws + WS_H2;
    int* TOKE = (int*)(F.ws + WS_TOKE); float* TOKW = (float*)(F.ws + WS_TOKW);
    LAS unsigned* hist = (LAS unsigned*)(F.lds + P7_HIST);
    LAS float* g2s = (LAS float*)(F.lds + P7_G2S);
    LAS float* LG = (LAS float*)(F.lds + P7_LG + F.wave * 2112);
    const int lane = F.lane, tok = lane & 15, g = lane >> 4, gw = F.vcu * NWAVES + F.wave, NGW = F.G * NWAVES, NT = T / 16;
    bf16x8 av[32];
#define P7_LOAD(tile_) { const bf16x8* xr_ = (const bf16x8*)(X1 + ((size_t)(tile_) * 16 + tok) * 1024) + 2 * g; \
        _Pragma("unroll") for (int kp = 0; kp < 16; ++kp) { av[2 * kp] = xr_[8 * kp]; av[2 * kp + 1] = xr_[8 * kp + 1]; } }
    for (int i = F.tid; i < 1024; i += 512) g2s[i] = 16.f * g2[i];
    for (int i = (int)blockIdx.x * 512 + F.tid; i < A_PAD; i += F.G * 512) ((int*)(F.ws + WS_SLOTT))[i] = 0;
    if (F.tid < 32) hist[F.tid] = 0u;
    {
        const v4u* src = (const v4u*)(F.ws + WS_WRB);
#pragma unroll 1
        for (int i0 = 0; i0 < 8192; i0 += 2048) { v4u t[4];
#pragma unroll
            for (int j = 0; j < 4; ++j) t[j] = src[i0 + j * 512 + F.tid];
#pragma unroll
            for (int j = 0; j < 4; ++j) *(LAS v4u*)(F.lds + 16 * (i0 + j * 512 + F.tid)) = t[j]; }
        if (F.tid < 64) *(LAS v4u*)(F.lds + 16 * (8192 + F.tid)) = src[8192 + F.tid];
    }
    __syncthreads();
    const float b0 = rb[tok], b1 = rb[16 + tok];
    const LAS unsigned char* bb = F.lds + tok * P7_WBROW + g * 32;
    for (int rep_ = 0; rep_ < nrep; ++rep_)
    for (int tile = gw; tile < NT; tile += NGW) {
        P7_LOAD(tile)
        f32x4 acc[4] = {{0.f, 0.f, 0.f, 0.f}, {0.f, 0.f, 0.f, 0.f}, {0.f, 0.f, 0.f, 0.f}, {0.f, 0.f, 0.f, 0.f}};
#define P7_BLOAD(ks_, h0_, h1_, l0_, l1_) { const int off_ = ((ks_) >> 1) * 128 + ((ks_) & 1) * 16; \
            h0_ = *(const LAS bf16x8*)(bb + off_); h1_ = *(const LAS bf16x8*)(bb + 16 * P7_WBROW + off_); l0_ = *(const LAS bf16x8*)(bb + P7_WBHALF + off_); l1_ = *(const LAS bf16x8*)(bb + P7_WBHALF + 16 * P7_WBROW + off_); }
        bf16x8 bq[2][4];
        P7_BLOAD(0, bq[0][0], bq[0][1], bq[0][2], bq[0][3])
#pragma unroll
        for (int ks = 0; ks < 32; ++ks) {
            if (ks + 1 < 32) P7_BLOAD(ks + 1, bq[(ks + 1) & 1][0], bq[(ks + 1) & 1][1], bq[(ks + 1) & 1][2], bq[(ks + 1) & 1][3])
            acc[0] = __builtin_amdgcn_mfma_f32_16x16x32_bf16(av[ks], bq[ks & 1][0], acc[0], 0, 0, 0);
            acc[1] = __builtin_amdgcn_mfma_f32_16x16x32_bf16(av[ks], bq[ks & 1][1], acc[1], 0, 0, 0);
            acc[2] = __builtin_amdgcn_mfma_f32_16x16x32_bf16(av[ks], bq[ks & 1][2], acc[2], 0, 0, 0);
            acc[3] = __builtin_amdgcn_mfma_f32_16x16x32_bf16(av[ks], bq[ks & 1][3], acc[3], 0, 0, 0);
            __builtin_amdgcn_sched_barrier(0);
        }
        float s0 = 0.f, s1 = 0.f, s2 = 0.f, s3 = 0.f;
#pragma unroll
        for (int i = 0; i < 32; ++i) { const v4u w = __builtin_bit_cast(v4u, av[i]);
            s0 = fmaf(bf_lo(w.x), bf_lo(w.x), s0); s1 = fmaf(bf_hi(w.x), bf_hi(w.x), s1); s2 = fmaf(bf_lo(w.y), bf_lo(w.y), s2); s3 = fmaf(bf_hi(w.y), bf_hi(w.y), s3);
            s0 = fmaf(bf_lo(w.z), bf_lo(w.z), s0); s1 = fmaf(bf_hi(w.z), bf_hi(w.z), s1); s2 = fmaf(bf_lo(w.w), bf_lo(w.w), s2); s3 = fmaf(bf_hi(w.w), bf_hi(w.w), s3); }
        float ss = (s0 + s1) + (s2 + s3); ss += __shfl_xor(ss, 16); ss += __shfl_xor(ss, 32);
        const float rs = 1.0f / sqrtf(ss * (1.f / 1024.f) + NORM_EPS);
        asm volatile("" ::: "memory");
        unsigned char* orow = H2 + ((size_t)tile * 16 + tok) * 1024 + 16 * g; const LAS float* gs = g2s + 16 * g;
#pragma unroll
        for (int kp = 0; kp < 16; ++kp) {
            v4u wa = __builtin_bit_cast(v4u, av[2 * kp]), wb = __builtin_bit_cast(v4u, av[2 * kp + 1]);
            asm volatile("" : "+v"(wa), "+v"(wb));
            const f32x4 ga = *(const LAS f32x4*)(gs + 64 * kp) * rs, gb = *(const LAS f32x4*)(gs + 64 * kp + 4) * rs, gc = *(const LAS f32x4*)(gs + 64 * kp + 8) * rs, gd = *(const LAS f32x4*)(gs + 64 * kp + 12) * rs;
            v4u o;
            o.x = pk4f8(bf_lo(wa.x) * ga.x, bf_hi(wa.x) * ga.y, bf_lo(wa.y) * ga.z, bf_hi(wa.y) * ga.w);
            o.y = pk4f8(bf_lo(wa.z) * gb.x, bf_hi(wa.z) * gb.y, bf_lo(wa.w) * gb.z, bf_hi(wa.w) * gb.w);
            o.z = pk4f8(bf_lo(wb.x) * gc.x, bf_hi(wb.x) * gc.y, bf_lo(wb.y) * gc.z, bf_hi(wb.y) * gc.w);
            o.w = pk4f8(bf_lo(wb.z) * gd.x, bf_hi(wb.z) * gd.y, bf_lo(wb.w) * gd.z, bf_hi(wb.w) * gd.w);
            *(v4u*)(orow + 64 * kp) = o;
            __builtin_amdgcn_sched_barrier(0);
        }
        __builtin_amdgcn_sched_barrier(0);
        const f32x4 d0 = acc[0] + acc[2], d1 = acc[1] + acc[3];
#pragma unroll
        for (int r = 0; r < 4; ++r) { const float rt = __shfl(rs, 4 * g + r); LG[(4 * g + r) * 33 + tok] = fmaf(d0[r], rt, b0); LG[(4 * g + r) * 33 + 16 + tok] = fmaf(d1[r], rt, b1); }
        __builtin_amdgcn_fence(__ATOMIC_RELEASE, "wavefront"); __builtin_amdgcn_wave_barrier(); __builtin_amdgcn_fence(__ATOMIC_ACQUIRE, "wavefront");
        float v0 = -INFINITY, v1 = -INFINITY, v2 = -INFINITY, v3 = -INFINITY; int e0 = 0, e1 = 0, e2 = 0, e3 = 0;
#pragma unroll
        for (int e = 0; e < 32; ++e) { const float x = LG[tok * 33 + e];
            const bool c0 = x > v0, c1 = x > v1, c2 = x > v2, c3 = x > v3;
            v3 = c2 ? v2 : (c3 ? x : v3); e3 = c2 ? e2 : (c3 ? e : e3);
            v2 = c1 ? v1 : (c2 ? x : v2); e2 = c1 ? e1 : (c2 ? e : e2);
            v1 = c0 ? v0 : (c1 ? x : v1); e1 = c0 ? e0 : (c1 ? e : e1);
            v0 = c0 ? x : v0;             e0 = c0 ? e : e0; }
        __builtin_amdgcn_wave_barrier();
        const float x1_ = __expf(v1 - v0), x2_ = __expf(v2 - v0), x3_ = __expf(v3 - v0); const float inv = 1.f / (1.f + x1_ + x2_ + x3_);
        const int row = tile * 16 + tok;
        if (g == 0) {
            *(int4*)(TOKE + (size_t)row * 4) = make_int4(e0, e1, e2, e3);
            *(f32x4*)(TOKW + (size_t)row * 4) = (f32x4){inv, x1_ * inv, x2_ * inv, x3_ * inv};
            if (rep_ == nrep - 1) { __hip_atomic_fetch_add(&hist[e0], 1u, __ATOMIC_RELAXED, __HIP_MEMORY_SCOPE_WORKGROUP); __hip_atomic_fetch_add(&hist[e1], 1u, __ATOMIC_RELAXED, __HIP_MEMORY_SCOPE_WORKGROUP);
                                    __hip_atomic_fetch_add(&hist[e2], 1u, __ATOMIC_RELAXED, __HIP_MEMORY_SCOPE_WORKGROUP); __hip_atomic_fetch_add(&hist[e3], 1u, __ATOMIC_RELAXED, __HIP_MEMORY_SCOPE_WORKGROUP); }
        }
    }
    __syncthreads();
    { int t_; asm volatile("v_mbcnt_lo_u32_b32 %0, -1, 0\n\tv_mbcnt_hi_u32_b32 %0, -1, %0" : "=v"(t_)); t_ += F.wave * 64;
      if (t_ < 32) { const unsigned base = __hip_atomic_fetch_add((unsigned*)(F.ctl + CW_CNT + t_), hist[t_], RLX_AGENT); ((int*)(F.ws + WS_WGB))[blockIdx.x * 32 + t_] = (int)base; } }
}

__device__ __forceinline__ void p8_scatter(Frame& F) {
    LAS int* seg = (LAS int*)F.lds;
    LAS int* lcnt = (LAS int*)(F.lds + 256);
    LAS int* wgb = (LAS int*)(F.lds + 512);
    int* tile_e = (int*)(F.ws + WS_TILEE);
    if (F.tid == 0) {
        int s = 0;
        for (int e = 0; e < 32; ++e) { seg[e] = s; const int c = (int)__hip_atomic_load((unsigned*)(F.ctl + CW_CNT + e), RLX_AGENT); s += (c + 255) & ~255; }
        seg[32] = s;
    }
    if (F.tid < 32) { lcnt[F.tid] = 0; wgb[F.tid] = ((const int*)(F.ws + WS_WGB))[blockIdx.x * 32 + F.tid]; }
    __syncthreads();
    if (blockIdx.x == 0) {
        for (int t = F.tid; t < MAX_TILES; t += 512) { int e = 0; for (int k = 1; k < 32; ++k) e += (seg[k] <= t * 256) ? 1 : 0; tile_e[t] = e; }
        if (F.tid == 0) tile_e[MAX_TILES] = seg[32] >> 8;
    }
    const int* TOKE = (const int*)(F.ws + WS_TOKE); const float* TOKW = (const float*)(F.ws + WS_TOKW); int* TOKS = (int*)(F.ws + WS_TOKS); float* SLOTW = (float*)(F.ws + WS_SLOTW);
    int* SLOTT = (int*)(F.ws + WS_SLOTT);
    const int lane = F.lane, gw = F.vcu * NWAVES + F.wave, NGW = F.G * NWAVES;
    for (int tile = gw; tile < T / 16; tile += NGW) {
        const int row = tile * 16 + (lane >> 2), k = lane & 3;
        const int e = TOKE[(size_t)row * 4 + k]; const int r = __hip_atomic_fetch_add(&lcnt[e], 1, __ATOMIC_RELAXED, __HIP_MEMORY_SCOPE_WORKGROUP);
        const int slot = seg[e] + wgb[e] + r; TOKS[(size_t)row * 4 + k] = slot; SLOTW[slot] = TOKW[(size_t)row * 4 + k]; SLOTT[slot] = row;
    }
}

__device__ __forceinline__ float f8_to_f32(unsigned w, int byte) { return byte == 0 ? __builtin_amdgcn_cvt_f32_fp8(w, 0) : byte == 1 ? __builtin_amdgcn_cvt_f32_fp8(w, 1) : byte == 2 ? __builtin_amdgcn_cvt_f32_fp8(w, 2) : __builtin_amdgcn_cvt_f32_fp8(w, 3); }
__device__ __forceinline__ void p11_final(Frame& F, const Args& a) {
    const float* gf = (const float*)a.in[18]; const bf16* X1 = (const bf16*)(F.ws + WS_X1); const unsigned char* Y8 = F.ws + WS_Y; const int* TOKS = (const int*)(F.ws + WS_TOKS);
    const int lane = F.lane, gw = F.vcu * NWAVES + F.wave, NGW = F.G * NWAVES;
    f32x4 gv[4];
#pragma unroll
    for (int j = 0; j < 4; ++j) gv[j] = *((const f32x4*)gf + lane + 64 * j);
    for (int row = gw; row < T; row += NGW) {
        const int4 sl = *(const int4*)(TOKS + (size_t)row * 4);
        const v2u* xr = (const v2u*)(X1 + (size_t)row * 1024) + lane; f32x4 v[4];
#pragma unroll
        for (int j = 0; j < 4; ++j) { const v2u w = xr[64 * j]; v[j] = (f32x4){bf_lo(w.x), bf_hi(w.x), bf_lo(w.y), bf_hi(w.y)}; }
        const int ss[4] = {sl.x, sl.y, sl.z, sl.w};
#pragma unroll
        for (int k = 0; k < 4; ++k) { const unsigned* yr = (const unsigned*)(Y8 + (size_t)ss[k] * 1024) + lane;
#pragma unroll
            for (int j = 0; j < 4; ++j) { const unsigned w = yr[64 * j];
                v[j].x += 0.0625f * f8_to_f32(w, 0); v[j].y += 0.0625f * f8_to_f32(w, 1); v[j].z += 0.0625f * f8_to_f32(w, 2); v[j].w += 0.0625f * f8_to_f32(w, 3); } }
        float s = 0.f;
#pragma unroll
        for (int j = 0; j < 4; ++j) s += (v[j].x * v[j].x + v[j].y * v[j].y) + (v[j].z * v[j].z + v[j].w * v[j].w);
        const float rs = 1.0f / sqrtf(wave_sum(s) * (1.f / 1024.f) + NORM_EPS);
        f32x4* o = (f32x4*)(a.out + (size_t)row * 1024) + lane;
#pragma unroll
        for (int j = 0; j < 4; ++j) __builtin_nontemporal_store(v[j] * rs * gv[j], o + 64 * j);
    }
}

constexpr int N_ITEMS_A = 640 + 768 + 256 + 128 + 128 + 128 + 1024, N_ITEMS_B = 1024;

__global__ void __launch_bounds__(NWAVES * 64, 2) hybrid_fwd(Args args) {
    extern __shared__ __attribute__((aligned(16))) unsigned char lds[];
    Frame F;
    F.lds = (LAS unsigned char*)lds;
    F.MISC = (volatile LAS unsigned*)(F.lds + MISC_OFF);
    F.tid = threadIdx.x; F.lane = F.tid & 63; F.wave = __builtin_amdgcn_readfirstlane(F.tid >> 6);
    F.G = gridDim.x; { const int bx = blockIdx.x; F.vcu = (F.G % 8 == 0) ? (bx % 8) * (F.G / 8) + bx / 8 : bx; }
    F.ws = args.ws; F.ctl = (gu32*)(args.ws + WS_CTL);
    for (int u = F.tid; u < (LDS_BYTES - LDSCTL_OFF) / 4; u += NWAVES * 64) ((LAS unsigned*)(F.lds + LDSCTL_OFF))[u] = 0u;
    __syncthreads();
    const int lo = args.ph_lo, hi = args.ph_hi;
    const bool multi = (hi - lo) > 1;
    XcdBarrier bar; bar.bar = (unsigned*)(F.ctl + CW_BAR); bar.x = 0; bar.st = nullptr;
    if (multi) bar = xcd_barrier_post((unsigned*)(F.ctl + CW_BAR), F.MISC + 8);
#ifndef PH_MASK
#define PH_MASK 0xfff
#endif
#define IN(k) (((PH_MASK >> (k)) & 1) && lo <= (k) && (k) < hi)
#ifndef REP_MASK
#define REP_MASK 0
#endif
#define NREPS(k) ((((REP_MASK) >> (k)) & 1) ? 1 + ((args.rep_mask >> (k)) & 1) : 1)
#define REP(k) _Pragma("unroll 1") for (int rep_ = 0; rep_ < ((((REP_MASK) >> (k)) & 1) ? 1 + ((args.rep_mask >> (k)) & 1) : 1); ++rep_)
#define FRESH() do { int t_ = threadIdx.x; asm volatile("" : "+v"(t_)); F.tid = t_; F.lane = t_ & 63; } while (0)
#ifdef DOUBLE_BAR
#define SEAM(k) do { if (IN(k) && IN((k) + 1)) { xcd_barrier(bar); xcd_barrier(bar); } } while (0)
#else
#define SEAM(k) do { if (IN(k) && IN((k) + 1)) xcd_barrier(bar); } while (0)
#endif
    unsigned char* ws = args.ws;
#define MAKE_AP() att::Ptrs AP; AP.ws = ws
    if (IN(0)) { FRESH(); REP(0) p0_prologue(F, args); SEAM(0); }
    if (IN(1)) { FRESH();
        pg8::Gemm g{(const bf16*)(ws + WS_H), (const bf16*)(ws + WS_WIN), 512, 512, 512, nullptr}; pg8::StaticOrder S; S.init(T, IN_PAD, F.G, (int)blockIdx.x, NREPS(1));
#ifdef EPI_TWICE
        g.epi2 = (EPI_TWICE == 1) ? ((args.rep_mask >> 16) & 1) : 0;
#endif
        epi::InProj E{(bf16*)(ws + WS_QC), (bf16*)(ws + WS_QR), (bf16*)(ws + WS_KV6), (bf16*)(ws + WS_F3), (bf16*)(ws + WS_G2), (float*)(ws + WS_SG), (const float*)(ws + WS_CS), (const float*)args.in[7]};
        pg8::gemm_phase<epi::InProj, pg8::StaticOrder, true, 0x7b7b7b7b>(F.lds + RING_OFF, g, S, E);
        SEAM(1);
    }
    if (IN(2)) { FRESH(); REP(2) p2_compress(F, args); SEAM(2); }
#ifdef STUB_ATTN
    if (IN(3)) { FRESH(); v4u* ao = (v4u*)(ws + WS_AO); for (size_t i = (size_t)blockIdx.x * 512 + F.tid; i < (size_t)T * 1024 / 8; i += (size_t)F.G * 512) ao[i] = (v4u){0u, 0u, 0u, 0u}; SEAM(3); }
    if (IN(4)) { FRESH(); SEAM(4); }
#else
#define ATTN_UNIT att::attn_unit2
    if (IN(3)) { FRESH();
        MAKE_AP();
        LAS int* qslot = (LAS int*)(F.lds + LDSCTL_OFF);
        const int nrep = 1 + ((args.rep_mask >> 3) & 1);
#ifdef CONV_INTERLEAVE
#define CONV_STEP() conv_one(F, args)
#else
#define CONV_STEP() do {} while (0)
#endif
#ifdef CONV_INTERLEAVE
#define CONV_DEDICATED 0
#else
#define CONV_DEDICATED (CONV_MOD != 0)
#endif
#ifdef CONV_NOWATCH
#define CONV_WATCH3 -1
#else
#define CONV_WATCH3 CW_Q3
#endif
#define RUN_QUEUE(CW, NITEMS, ...) for (;;) { __syncthreads(); \
            if (F.tid == 0) qslot[0] = (int)__hip_atomic_fetch_add((unsigned*)(F.ctl + (CW)), 1u, RLX_AGENT); \
            __syncthreads(); int it = qslot[0]; if (it >= (NITEMS) * QREP(CW)) break; if (it >= (NITEMS)) it -= (NITEMS); __VA_ARGS__; }
#ifdef REPQ
#define QREP(CW) ((CW) == (REPQ) ? nrep : 1)
#else
#define QREP(CW) nrep
#endif
        if (CONV_DEDICATED && (int)blockIdx.x % (CONV_MOD ? CONV_MOD : 1) == 0) conv_drain(F, args, CONV_WATCH3, 1024);
#ifndef SKIPQ0
        RUN_QUEUE(CW_Q0, 512, { const int qb = 7 - it / 64, r_ = it % 64; ATTN_UNIT<0>(r_ >> 2, r_ & 3, qb, AP, (LAS char*)F.lds); CONV_STEP(); });
#endif
#ifndef SKIPQ2
        RUN_QUEUE(CW_Q2, 512, { const int qb = 7 - it / 64, r_ = it % 64; ATTN_UNIT<1>(r_ >> 2, r_ & 3, qb, AP, (LAS char*)F.lds); CONV_STEP(); });
#endif
#ifndef SKIPQ3
        RUN_QUEUE(CW_Q3, 1024, { att::cmp_unit(it >> 6, (it >> 5) & 1, it & 31, AP, (LAS char*)F.lds); CONV_STEP(); });
#endif
        SEAM(3);
    }
#ifdef P4_COPY
    if (IN(4)) { FRESH(); const v4u* srcp = (const v4u*)(ws + (P4_COPY == 1 ? WS_OW : WS_OC)); for (size_t i = (size_t)blockIdx.x * 512 + F.tid; i < (size_t)T * 64; i += (size_t)F.G * 512) { const size_t r = i >> 6, c = i & 63; ((v4u*)(ws + WS_AO))[r * 128 + c] = srcp[i]; } SEAM(4); }
    if (0) {
#elif defined(ONLY_FOX)
    if (IN(4)) { FRESH(); for (size_t i = (size_t)blockIdx.x * 512 + F.tid; i < (size_t)T * 64; i += (size_t)F.G * 512) { const size_t r = i >> 6, c = i & 63; ((v4u*)(ws + WS_AO))[r * 128 + c] = (v4u){0u, 0u, 0u, 0u}; } SEAM(4); }
    if (0) {
#else
    if (IN(4)) { FRESH();
#endif
        MAKE_AP();
        LAS int* qslot = (LAS int*)(F.lds + LDSCTL_OFF);
        const int nrep = 1 + ((args.rep_mask >> 4) & 1);
        if (CONV_DEDICATED && (int)blockIdx.x % (CONV_MOD ? CONV_MOD : 1) == 0) conv_drain(F, args, CW_Q1, 512);
        RUN_QUEUE(CW_Q1, 512, { const int qb = 7 - it / 64, r_ = it % 64; ATTN_UNIT<2>(r_ >> 2, r_ & 3, qb, AP, (LAS char*)F.lds); CONV_STEP(); CONV_STEP(); });
        if (CONV_MOD != 0) conv_drain(F, args, -1, 0);
        SEAM(4);
    }
#endif
    if (IN(5)) { FRESH();
        pg8::StaticOrder S; S.init(T, 1024, F.G, (int)blockIdx.x, NREPS(5));
        { pg8::Gemm g{(const bf16*)(ws + WS_AO), (const bf16*)(ws + WS_WP), 1024, 1024, 1024, nullptr};
#ifdef EPI_TWICE
        g.epi2 = (EPI_TWICE == 5) ? ((args.rep_mask >> 16) & 1) : 0;
#endif
          epi::GateMix E{(const bf16*)(ws + WS_G2), (const bf16*)(ws + WS_G2) + (size_t)T * 1024, (bf16*)(ws + WS_MX)};
          pg8::gemm_phase<epi::GateMix, pg8::StaticOrder, true>(F.lds + RING_OFF, g, S, E); }
        SEAM(5);
    }
    if (IN(6)) { FRESH();
        pg8::Gemm g{(const bf16*)(ws + WS_MX), (const bf16*)(ws + WS_WOUT), 1024, 1024, 1024, nullptr}; pg8::StaticOrder S; S.init(T, 1024, F.G, (int)blockIdx.x, NREPS(6));
#ifdef EPI_TWICE
        g.epi2 = (EPI_TWICE == 6) ? ((args.rep_mask >> 16) & 1) : 0;
#endif
        epi::ResOut E{(const float*)args.in[0], (bf16*)(ws + WS_X1)};
        pg8::gemm_phase<epi::ResOut, pg8::StaticOrder, true>(F.lds + RING_OFF, g, S, E);
        SEAM(6);
    }
    if (IN(7)) { FRESH(); p7_route(F, args, NREPS(7)); SEAM(7); }
    if (IN(8)) { FRESH(); p8_scatter(F); SEAM(8); }
    if (IN(9)) { FRESH();
        const int* tile_e = (const int*)(ws + WS_TILEE); const int nMt = __builtin_amdgcn_readfirstlane(tile_e[MAX_TILES]);
        pg8::Gemm g{(const bf16*)(ws + WS_H2), (const bf16*)(ws + WS_W1), 512, 512, 512, (const int*)(ws + WS_SLOTT)};
#ifdef EPI_TWICE
        g.epi2 = (EPI_TWICE == 9) ? ((args.rep_mask >> 16) & 1) : 0;
#endif
        LAS int* te_l = (LAS int*)(F.lds + 131072); for (int i = F.tid; i < MAX_TILES; i += 512) te_l[i] = tile_e[i]; __syncthreads();
        pg8::MoeOrder S; S.init(nMt, 8, F.G, (int)blockIdx.x, te_l, NREPS(9));
        epi::Moe1 E{(const float*)args.in[15], ws + WS_ACT};
        pg8::gemm_phase<epi::Moe1, pg8::MoeOrder, MOE_ALIGN, 0x7b7b7b7b, true>(F.lds + RING_OFF, g, S, E);
        SEAM(9);
    }
    if (IN(10)) { FRESH();
        const int* tile_e = (const int*)(ws + WS_TILEE); const int nMt = __builtin_amdgcn_readfirstlane(tile_e[MAX_TILES]);
        pg8::Gemm g{(const bf16*)(ws + WS_ACT), (const bf16*)(ws + WS_W2), 512, 512, 512, nullptr}; LAS int* te_l = (LAS int*)(F.lds + 131072); for (int i = F.tid; i < MAX_TILES; i += 512) te_l[i] = tile_e[i]; __syncthreads();
#ifdef EPI_TWICE
        g.epi2 = (EPI_TWICE == 10) ? ((args.rep_mask >> 16) & 1) : 0;
#endif
        pg8::MoeOrder S; S.init(nMt, 4, F.G, (int)blockIdx.x, te_l, NREPS(10));
        epi::Moe2 E{(const float*)args.in[17], (const float*)(ws + WS_SLOTW), ws + WS_Y};
        pg8::gemm_phase<epi::Moe2, pg8::MoeOrder, MOE_ALIGN, 0x7d7d7d7d>(F.lds + RING_OFF, g, S, E);
        SEAM(10);
    }
    if (IN(11)) { FRESH(); REP(11) p11_final(F, args); }
#undef IN
#undef SEAM
}

#ifndef MK_PER_PHASE
#define MK_PER_PHASE 0
#endif
extern "C" void kernel_launch(void* const* d_in, const int* in_sizes, int n_in, void* d_out, int out_size, void* d_ws, size_t ws_size, hipStream_t stream) {
    static int grid = 0;
    if (grid == 0) {
        if (n_in != 19 || out_size != T * D_MODEL || ws_size < WS_END) { fprintf(stderr, "kernel_launch: unexpected shapes (n_in %d, out %d, ws %zu)\n", n_in, out_size, ws_size); grid = -1; return; }
        int dev = 0, cus = 0, per_cu = 0;
        if (hipGetDevice(&dev) != hipSuccess || hipDeviceGetAttribute(&cus, hipDeviceAttributeMultiprocessorCount, dev) != hipSuccess) { grid = -1; return; }
        if (hipFuncSetAttribute((const void*)hybrid_fwd, hipFuncAttributeMaxDynamicSharedMemorySize, LDS_BYTES) != hipSuccess) { fprintf(stderr, "kernel_launch: hipFuncSetAttribute failed\n"); grid = -1; return; }
        if (hipOccupancyMaxActiveBlocksPerMultiprocessor(&per_cu, (const void*)hybrid_fwd, NWAVES * 64, LDS_BYTES) != hipSuccess || per_cu < 1) { fprintf(stderr, "kernel_launch: occupancy query reports %d\n", per_cu); }
        (void)hipGetLastError();
        grid = cus;
    }
    if (grid < 0) return;
    (void)hipMemsetAsync((char*)d_ws + WS_CTL, 0, CTL_ZERO_BYTES, stream);
    Args a{};
    for (int i = 0; i < 19; ++i) a.in[i] = d_in[i];
    a.out = (float*)d_out; a.ws = (unsigned char*)d_ws; a.rep_mask = REP_MASK;
#if MK_PER_PHASE
    for (int p = 0; p < 12; ++p) { a.ph_lo = p; a.ph_hi = p + 1; hipLaunchKernelGGL(hybrid_fwd, dim3(grid), dim3(NWAVES * 64), LDS_BYTES, stream, a); }
#else
    a.ph_lo = 0; a.ph_hi = 12;
    hipLaunchKernelGGL(hybrid_fwd, dim3(grid), dim3(NWAVES * 64), LDS_BYTES, stream, a);
#endif
}
```

```cpp
#include <hip/hip_runtime.h>
#include <cstdio>
#include <cstdint>

#ifndef PG8_WGM
#define PG8_WGM 8
#endif
namespace pg8 {
#define PG8_LAS __attribute__((address_space(3)))
typedef unsigned short bf16_t;
typedef short bf16x8 __attribute__((ext_vector_type(8)));
typedef float f32x4 __attribute__((ext_vector_type(4)));
typedef unsigned u32x4 __attribute__((ext_vector_type(4)));
typedef int i32x4 __attribute__((ext_vector_type(4)));
typedef int i32x8 __attribute__((ext_vector_type(8)));
constexpr int SIDE_OFF = 131072 + 4096;
constexpr int BM = 256, BK = 64, HALF = 128, HTB = HALF * BK * 2  , STAGE_BYTES = 8 * HTB, NXCD = 8, WGM = PG8_WGM;

__host__ __device__ __forceinline__ int lds_byte(int r, int c) { const int st = (r >> 4) * 2 + (c >> 5), rr = r & 15, cc = c & 31, ob = rr * 64 + cc * 2; return st * 1024 + (ob ^ (((ob >> 9) & 1) << 5)); }
__host__ __device__ __forceinline__ void stage_rc(int b, int& R, int& C) { const int st = b / 1024, sb = b % 1024, swz = sb ^ (((sb >> 9) & 1) << 5); R = (st >> 1) * 16 + swz / 64; C = (st & 1) * 32 + (swz % 64) / 2; }
__host__ __device__ __forceinline__ int perm32(int rho) { const int n = rho >> 4, i = rho & 15; return 8 * (i >> 2) + 4 * n + (i & 3); }

struct Unit { int pm, pn; };
struct Gemm { const bf16_t* A; const bf16_t* Bt; int K, lda, ldb; const int* rowmap; int epi2; };

__host__ __device__ __forceinline__ int udiv_small(int x, int d, int& rem) {
#ifdef __HIP_DEVICE_COMPILE__
    int q = (int)((float)x * __builtin_amdgcn_rcpf((float)d));
#else
    int q = x / d;
#endif
    int r = x - q * d; if (r < 0) { --q; r += d; } if (r >= d) { ++q; r -= d; } rem = r; return q;
}
struct StaticOrder {
    int nM, nN, nwg, G, c, reps;
    __host__ __device__ void init(int M, int N, int G_, int c_, int reps_ = 1) { nM = M / BM; nN = N / BM; nwg = nM * nN; G = G_; c = c_; reps = reps_; }
    __host__ __device__ bool next(int i, Unit& u) const {
        const int L = i * G + c; if (L >= nwg * reps) return false;
        int wgid = L >= nwg ? L - nwg : L; { const int q = nwg >> 3, r = nwg & 7, xcd = wgid & 7, off = wgid >> 3; wgid = (xcd < r ? xcd * (q + 1) : r * (q + 1) + (xcd - r) * q) + off; }
        int w, j; const int nig = WGM * nN, gid = udiv_small(wgid, nig, w), fm = gid * WGM, gsz = (nM - fm) < WGM ? (nM - fm) : WGM;
        u.pn = udiv_small(w, gsz, j); u.pm = fm + j; return true;
    }
};
struct MoeOrder {
    int nM, nN, nwg, G, c, reps; const PG8_LAS int* tile_e;
    __device__ void init(int nM_, int nN_, int G_, int c_, const PG8_LAS int* te, int reps_ = 1) { nM = nM_; nN = nN_; nwg = nM * nN; G = G_; c = c_; tile_e = te; reps = reps_; }
    __device__ bool next(int i, Unit& u) const {
        const int L = i * G + c; if (L >= nwg * reps) return false;
        int wgid = L >= nwg ? L - nwg : L; { const int q = nwg >> 3, r = nwg & 7, xcd = wgid & 7, off = wgid >> 3; wgid = (xcd < r ? xcd * (q + 1) : r * (q + 1) + (xcd - r) * q) + off; }
        int w, j; const int nig = WGM * nN, gid = udiv_small(wgid, nig, w), fm = gid * WGM, gsz = (nM - fm) < WGM ? (nM - fm) : WGM;
        const int pn = udiv_small(w, gsz, j), pm = fm + j;
        const int e = __builtin_amdgcn_readfirstlane(tile_e[pm]);
        u.pm = pm; u.pn = e * nN + pn; return true;
    }
};

typedef float f32x2_t __attribute__((ext_vector_type(2))); typedef __bf16 bf16x2_t __attribute__((ext_vector_type(2)));
__device__ __forceinline__ unsigned cvt_pk_bf16(float lo, float hi) { f32x2_t v = {lo, hi}; bf16x2_t b = __builtin_convertvector(v, bf16x2_t); return __builtin_bit_cast(unsigned, b); }

template <class Epi, class Sched, bool ALIGN_EPI, int FP8 = 0, bool GATHER = false>
__device__ __forceinline__ void gemm_phase(PG8_LAS unsigned char* lds, const Gemm g, const Sched& S, const Epi& E) {
    const int tid = threadIdx.x, wid = __builtin_amdgcn_readfirstlane(tid >> 6), lane = tid & 63, wr = wid >> 2, wc = wid & 3, fr = lane & 15, fq = lane >> 4;
    const int K = g.K, nt = K / BK;
    unsigned voffA[2], voffB[2];
#pragma unroll
    for (int i = 0; i < 2; ++i) { int R, C; stage_rc(tid * 16 + i * 8192, R, C); const int Rb = Epi::PERM ? ((R & ~31) + perm32(R & 31)) : R;
        voffA[i] = (unsigned)(R * g.lda + C) * 2u; voffB[i] = (unsigned)(Rb * g.ldb + C) * 2u; }
    unsigned goffC[2][2], goffN[2][2];
#define PG8_GOFF(dst, pm_) do { _Pragma("unroll") for (int i_ = 0; i_ < 2; ++i_) { int R_, C_; stage_rc(tid * 16 + i_ * 8192, R_, C_);   \
        _Pragma("unroll") for (int h_ = 0; h_ < 2; ++h_) dst[h_][i_] = (unsigned)g.rowmap[(pm_) * BM + h_ * HALF + R_] * (unsigned)(g.lda * 2) + (unsigned)C_ * 2u; } } while (0)
#define PG8_GOFF_DMA(pm_, side_) do { if (wid == 2) __builtin_amdgcn_global_load_lds((const unsigned*)(g.rowmap + (size_t)(pm_) * BM + lane * 4), (PG8_LAS unsigned*)((side_) + 1024), 16, 0, 0); } while (0)
#define PG8_GOFF_FIN(dst, side_) do { _Pragma("unroll") for (int i_ = 0; i_ < 2; ++i_) { int R_, C_; stage_rc(tid * 16 + i_ * 8192, R_, C_); \
        _Pragma("unroll") for (int h_ = 0; h_ < 2; ++h_) dst[h_][i_] = (unsigned)((const PG8_LAS int*)((side_) + 1024))[h_ * HALF + R_] * (unsigned)(g.lda * 2) + (unsigned)C_ * 2u; } } while (0)
    const size_t kstep = (size_t)(BK * 2);
    const size_t hstepA = (size_t)HALF * g.lda * 2, hstepB = (size_t)HALF * g.ldb * 2;
    const size_t tstepA = 2 * hstepA, tstepB = 2 * hstepB;
    const unsigned ldsw = (unsigned)wid * 1024u;
    const int aoff = lds_byte(wr * 64 + fr, fq * 8), boff = lds_byte(wc * 32 + fr, fq * 8);
#define PG8_SA(b, h) (((b) * 2 + (h)) * HTB)
#define PG8_SB(b, h) ((4 + (b) * 2 + (h)) * HTB)
#define PG8_STAGE(bufoff, gbase, voff) do { _Pragma("unroll") for (int _i = 0; _i < 2; ++_i) \
        __builtin_amdgcn_global_load_lds((const unsigned*)((const char*)(gbase) + (voff)[_i]), (PG8_LAS unsigned*)(lds + (bufoff) + ldsw + _i * 8192), 16, 0, 0); } while (0)
#define PG8_STAGE_A(bufoff, ptr_, kb_, h_, useN_) do { if constexpr (GATHER) { if (useN_) { _Pragma("unroll") for (int _i = 0; _i < 2; ++_i)   \
        __builtin_amdgcn_global_load_lds((const unsigned*)((const char*)g.A + (kb_) + goffN[h_][_i]), (PG8_LAS unsigned*)(lds + (bufoff) + ldsw + _i * 8192), 16, 0, 0); } \
        else { _Pragma("unroll") for (int _i = 0; _i < 2; ++_i) \
        __builtin_amdgcn_global_load_lds((const unsigned*)((const char*)g.A + (kb_) + goffC[h_][_i]), (PG8_LAS unsigned*)(lds + (bufoff) + ldsw + _i * 8192), 16, 0, 0); } } \
        else PG8_STAGE(bufoff, ptr_, voffA); } while (0)
#define PG8_LDA(dst, b, h) do { if constexpr (FP8 != 0) { _Pragma("unroll") for (int m = 0; m < 4; ++m) { const i32x4 lo_ = *(const PG8_LAS i32x4*)(lds + PG8_SA(b, h) + aoff + m * 2048), hi_ = *(const PG8_LAS i32x4*)(lds + PG8_SA(b, h) + aoff + m * 2048 + 1024); A8[m] = __builtin_shufflevector(lo_, hi_, 0, 1, 2, 3, 4, 5, 6, 7); } } \
        else { _Pragma("unroll") for (int m = 0; m < 4; ++m) _Pragma("unroll") for (int k = 0; k < 2; ++k) dst[m][k] = *(const PG8_LAS bf16x8*)(lds + PG8_SA(b, h) + aoff + m * 2048 + k * 1024); } } while (0)
#define PG8_LDB(dst, b, h) do { if constexpr (FP8 != 0) { _Pragma("unroll") for (int n = 0; n < 2; ++n) { const i32x4 lo_ = *(const PG8_LAS i32x4*)(lds + PG8_SB(b, h) + boff + n * 2048), hi_ = *(const PG8_LAS i32x4*)(lds + PG8_SB(b, h) + boff + n * 2048 + 1024); dst##8[n] = __builtin_shufflevector(lo_, hi_, 0, 1, 2, 3, 4, 5, 6, 7); } } \
        else { _Pragma("unroll") for (int n = 0; n < 2; ++n) _Pragma("unroll") for (int k = 0; k < 2; ++k) dst[n][k] = *(const PG8_LAS bf16x8*)(lds + PG8_SB(b, h) + boff + n * 2048 + k * 1024); } } while (0)
#ifdef MMA_TWICE
#define PG8_MMA_EXTRA(acc_, b_, a_) asm volatile("v_mfma_scale_f32_16x16x128_f8f6f4 %0, %1, %2, %0, %3, %3 op_sel_hi:[0,0,0]" : "+v"(acc_) : "v"(b_), "v"(a_), "v"(sclZ_));
#else
#define PG8_MMA_EXTRA(acc_, b_, a_)
#endif
#define PG8_MMA(ai, bj, At, Bt) do { __builtin_amdgcn_s_setprio(1); _Pragma("unroll") for (int m = 0; m < 4; ++m) _Pragma("unroll") for (int n = 0; n < 2; ++n) { \
        if constexpr (FP8 != 0) { asm volatile("v_mfma_scale_f32_16x16x128_f8f6f4 %0, %1, %2, %0, %3, %4 op_sel_hi:[0,0,0]" : "+v"(acc[ai][bj][m][n]) : "v"(Bt##8[n]), "v"(A8[m]), "v"(sclB_), "v"(sclA_));   \
          PG8_MMA_EXTRA(acc[ai][bj][m][n], Bt##8[n], A8[m]) } \
        else { _Pragma("unroll") for (int k = 0; k < 2; ++k) acc[ai][bj][m][n] = __builtin_amdgcn_mfma_f32_16x16x32_bf16(Bt[n][k], At[m][k], acc[ai][bj][m][n], 0, 0, 0); } } \
        __builtin_amdgcn_s_setprio(0); } while (0)
#define PG8_MMA0(ai, bj, At, Bt) do { __builtin_amdgcn_s_setprio(1); _Pragma("unroll") for (int m = 0; m < 4; ++m) _Pragma("unroll") for (int n = 0; n < 2; ++n) { \
        if constexpr (FP8 != 0) { asm volatile("v_mfma_scale_f32_16x16x128_f8f6f4 %0, %1, %2, 0, %3, %4 op_sel_hi:[0,0,0]" : "=&v"(acc[ai][bj][m][n]) : "v"(Bt##8[n]), "v"(A8[m]), "v"(sclB_), "v"(sclA_)); } \
        else { acc[ai][bj][m][n] = __builtin_amdgcn_mfma_f32_16x16x32_bf16(Bt[n][0], At[m][0], (f32x4){0.f, 0.f, 0.f, 0.f}, 0, 0, 0); acc[ai][bj][m][n] = __builtin_amdgcn_mfma_f32_16x16x32_bf16(Bt[n][1], At[m][1], acc[ai][bj][m][n], 0, 0, 0); } } \
        __builtin_amdgcn_s_setprio(0); } while (0)
#define PG8_WAIT_V(n) asm volatile("s_waitcnt vmcnt(" #n ")" ::: "memory")
#define PG8_WAIT_VREL() do { if constexpr (Epi::NSTORES > 0) { if (rel) asm volatile("s_waitcnt vmcnt(%0)" :: "n"(8 + Epi::NSTORES) : "memory"); else PG8_WAIT_V(8); } else PG8_WAIT_V(8); } while (0)
#define PG8_WAIT_L(n) asm volatile("s_waitcnt lgkmcnt(" #n ")" ::: "memory")
#define PG8_BAR __builtin_amdgcn_s_barrier()
#define PG8_SCHED __builtin_amdgcn_sched_barrier(0)
    Unit cur, nxt; int ui = 0;
    if (!S.next(0, cur)) return;
    f32x4 acc[2][2][4][2];
    if constexpr (!Epi::MMA0) {
#pragma unroll
    for (int a = 0; a < 2; ++a)
#pragma unroll
        for (int b = 0; b < 2; ++b)
#pragma unroll
            for (int m = 0; m < 4; ++m)
#pragma unroll
                for (int n = 0; n < 2; ++n) acc[a][b][m][n] = (f32x4){0.f, 0.f, 0.f, 0.f};
    }
    const int sclB_ = 0x79797979, sclA_ = FP8; const int sclZ_ = 0; (void)sclZ_;
    bf16x8 At[4][2], B0[2][2], B1[2][2]; i32x8 A8[4], B08[2], B18[2];
    const char* cA = (const char*)g.A + (size_t)cur.pm * tstepA; const char* cB = (const char*)g.Bt + (size_t)cur.pn * tstepB;
    if constexpr (GATHER) { PG8_GOFF(goffC, cur.pm); _Pragma("unroll") for (int h_ = 0; h_ < 2; ++h_) _Pragma("unroll") for (int i_ = 0; i_ < 2; ++i_) goffN[h_][i_] = goffC[h_][i_]; }
    PG8_STAGE(PG8_SB(0, 0), cB, voffB); PG8_STAGE(PG8_SB(0, 1), cB + hstepB, voffB); PG8_STAGE_A(PG8_SA(0, 0), cA, 0, 0, false); PG8_STAGE_A(PG8_SA(0, 1), cA + hstepA, 0, 1, false);
    if (wr == 1) PG8_BAR;
    PG8_WAIT_V(2); PG8_BAR;
    PG8_STAGE(PG8_SB(1, 0), cB + kstep, voffB); PG8_STAGE_A(PG8_SA(1, 0), cA + kstep, kstep, 0, false); PG8_STAGE(PG8_SB(1, 1), cB + hstepB + kstep, voffB);
    PG8_WAIT_V(6); PG8_BAR;
    for (;;) {
        typename Epi::Pre pre_; E.prefetch(pre_, cur, wc, fq, wid, lane, lds + SIDE_OFF + (ui & 1) * 2048);
        const bool has_next = S.next(ui + 1, nxt);
        const char* nA = has_next ? (const char*)g.A + (size_t)nxt.pm * tstepA : cA; const char* nB = has_next ? (const char*)g.Bt + (size_t)nxt.pn * tstepB : cB;
        bool nraw = false; if constexpr (GATHER) { if (has_next) { PG8_GOFF_DMA(nxt.pm, lds + SIDE_OFF + (ui & 1) * 2048); nraw = true; } }

#pragma unroll 1
        for (int t = 0; t < nt; t += 2) {
            const bool last = (t == nt - 2);
            const bool rel = (Epi::NSTORES > 0) && (t == 0) && (ui > 0);
            const char* a1 = cA + (size_t)(t + 1) * kstep;
            const char* a2 = last ? nA : cA + (size_t)(t + 2) * kstep; const char* b2 = last ? nB : cB + (size_t)(t + 2) * kstep;
            const char* a3 = a2 + kstep; const char* b3 = b2 + kstep;
            const size_t kb1 = (size_t)(t + 1) * kstep, kb2 = last ? 0 : (size_t)(t + 2) * kstep, kb3 = kb2 + kstep;
            if constexpr (GATHER) { if (nraw && t == 2) { PG8_GOFF_FIN(goffN, lds + SIDE_OFF + (ui & 1) * 2048); nraw = false; } }
            if constexpr (Epi::HAS_MID) { if (t == nt / 2) E.mid(acc, cur, wr, wc, fr, fq); }
            PG8_LDB(B0, 0, 0); PG8_LDB(B1, 0, 1); PG8_SCHED; PG8_LDA(At, 0, 0); if (!rel) PG8_STAGE_A(PG8_SA(1, 1), a1 + hstepA, kb1, 1, false);
            PG8_WAIT_VREL(); PG8_WAIT_L(0); PG8_BAR; if (Epi::MMA0 && t == 0) { PG8_MMA0(0, 0, At, B0); PG8_MMA0(0, 1, At, B1); } else { PG8_MMA(0, 0, At, B0); PG8_MMA(0, 1, At, B1); } PG8_BAR; PG8_SCHED;
            PG8_LDA(At, 0, 1); PG8_STAGE(PG8_SB(0, 0), b2, voffB); PG8_STAGE(PG8_SB(0, 1), b2 + hstepB, voffB); PG8_STAGE_A(PG8_SA(0, 0), a2, kb2, 0, last);
            PG8_WAIT_VREL(); PG8_WAIT_L(0); PG8_BAR; if (Epi::MMA0 && t == 0) { PG8_MMA0(1, 0, At, B0); PG8_MMA0(1, 1, At, B1); } else { PG8_MMA(1, 0, At, B0); PG8_MMA(1, 1, At, B1); } PG8_BAR; PG8_SCHED;
            PG8_LDB(B0, 1, 0); PG8_LDB(B1, 1, 1); PG8_SCHED; PG8_LDA(At, 1, 0); PG8_STAGE_A(PG8_SA(0, 1), a2 + hstepA, kb2, 1, last);
            PG8_WAIT_VREL(); PG8_WAIT_L(0); PG8_BAR; PG8_MMA(0, 0, At, B0); PG8_MMA(0, 1, At, B1); PG8_BAR; PG8_SCHED;
            PG8_LDA(At, 1, 1); PG8_STAGE(PG8_SB(1, 0), b3, voffB); PG8_STAGE(PG8_SB(1, 1), b3 + hstepB, voffB); PG8_STAGE_A(PG8_SA(1, 0), a3, kb3, 0, last);
            PG8_WAIT_V(8); PG8_WAIT_L(0); PG8_BAR; PG8_MMA(1, 0, At, B0); PG8_MMA(1, 1, At, B1); PG8_BAR; PG8_SCHED;
        }
        if constexpr (Epi::NSTORES > 0) PG8_STAGE_A(PG8_SA(1, 1), nA + kstep + hstepA, kstep, 1, true);
        if constexpr (ALIGN_EPI) { if (wr == 0) PG8_BAR; }
        if constexpr (FP8 != 0) asm volatile("s_nop 15\n\ts_nop 15" ::: "memory");
        E(acc, cur, wr, wc, fr, fq, pre_, lds + SIDE_OFF + (ui & 1) * 2048);
#ifdef EPI_TWICE
        if (g.epi2) E(acc, cur, wr, wc, fr, fq, pre_, lds + SIDE_OFF + (ui & 1) * 2048);
#endif
        if (!has_next) break;
    if constexpr (!Epi::MMA0) {
#pragma unroll
        for (int a = 0; a < 2; ++a)
#pragma unroll
            for (int b = 0; b < 2; ++b)
#pragma unroll
                for (int m = 0; m < 4; ++m)
#pragma unroll
                    for (int n = 0; n < 2; ++n) acc[a][b][m][n] = (f32x4){0.f, 0.f, 0.f, 0.f};
    }
        cur = nxt; cA = nA; cB = nB; ++ui;
        if constexpr (GATHER) { _Pragma("unroll") for (int h_ = 0; h_ < 2; ++h_) _Pragma("unroll") for (int i_ = 0; i_ < 2; ++i_) goffC[h_][i_] = goffN[h_][i_]; }
        if constexpr (ALIGN_EPI) { if (wr == 1) PG8_BAR; }
    }
    PG8_WAIT_V(0);
    if constexpr (!ALIGN_EPI) { if (wr == 0) PG8_BAR; }
    PG8_BAR;
#undef PG8_SA
#undef PG8_SB
#undef PG8_STAGE
#undef PG8_STAGE_A
#undef PG8_GOFF
#undef PG8_LDA
#undef PG8_LDB
#undef PG8_MMA
#undef PG8_WAIT_V
#undef PG8_WAIT_L
#undef PG8_BAR
#undef PG8_SCHED
}
}

constexpr int NWAVES = 8;
constexpr int D_MODEL = 1024, BATCH = 16, SEQ = 2048, T = BATCH * SEQ;
constexpr int HD = 64, NSA_H = 8, NSA_G = 2, FOX_H = 8;
constexpr int IN_COLS = 4896, IN_PAD = 5120;
constexpr int N_EXP = 32, TOPK = 4, D_FF = 1024;
constexpr int A_PAD = 139264;
constexpr int MAX_TILES = A_PAD / 256;
constexpr float NORM_EPS = 1e-6f;
constexpr float LOG2E = 1.4426950408889634f;
constexpr float QSCALE = 0.125f * LOG2E;

constexpr size_t MiB = 1u << 20;
constexpr size_t WS_CTL = 0, CTL_ZERO_BYTES = 65536;
constexpr size_t WS_CCONST = 1 * MiB;
constexpr size_t WS_SN = 1 * MiB + 4096;
constexpr size_t WS_WGB = 1 * MiB + 65536;
constexpr size_t WS_TILEE = 1 * MiB + 131072;
constexpr size_t WS_WRB = 1 * MiB + 262144;
constexpr size_t WS_WIN = 2 * MiB;
constexpr size_t WS_WP = 12 * MiB;
constexpr size_t WS_WOUT = 14 * MiB;
constexpr size_t WS_W1C = 16 * MiB;
constexpr size_t WS_CS = 18 * MiB;
constexpr size_t WS_TOKE = 20 * MiB;
constexpr size_t WS_TOKW = 20 * MiB + 524288;
constexpr size_t WS_TOKS = 21 * MiB;
constexpr size_t WS_SLOTW = 21 * MiB + 524288;
constexpr size_t WS_SLOTT = 22 * MiB + 524288;
constexpr size_t WS_SELM = 24 * MiB;
constexpr size_t WS_KCMP = 25 * MiB;
constexpr size_t WS_VCMP = 26 * MiB;
constexpr size_t WS_C2 = 27 * MiB;
constexpr size_t WS_SG = 28 * MiB;
constexpr size_t WS_W1 = 32 * MiB;
constexpr size_t WS_W2 = 160 * MiB;
constexpr size_t WS_X1 = 224 * MiB;
constexpr size_t WS_XIN = 352 * MiB;
constexpr size_t WS_Y = 352 * MiB;
constexpr size_t WS_ACT = 624 * MiB;
constexpr size_t WS_H = 352 * MiB;
constexpr size_t WS_TMP = 352 * MiB;
constexpr size_t WS_QC = 416 * MiB;
constexpr size_t WS_QR = 448 * MiB;
constexpr size_t WS_MX = 416 * MiB;
constexpr size_t WS_KV6 = 480 * MiB;
constexpr size_t WS_F3 = 528 * MiB;
constexpr size_t WS_G2 = 624 * MiB;
constexpr size_t WS_OC = 752 * MiB;
constexpr size_t WS_OW = 784 * MiB;
constexpr size_t WS_AO = 816 * MiB;
constexpr size_t WS_H2 = 896 * MiB;
constexpr size_t WS_END = 960 * MiB;
constexpr int CW_Q0 = 64, CW_Q1 = 128, CW_Q2 = 256, CW_Q3 = 320, CW_QC = 384;
constexpr int CW_CNT = 192;
constexpr int CW_BAR = 4096;

constexpr int RING_OFF = 0, RING_BYTES = 131072;
constexpr int LDSCTL_OFF = 162816, MISC_OFF = LDSCTL_OFF + 320;
constexpr int LDS_BYTES = 163840;

#define GAS __attribute__((address_space(1)))
#define LAS __attribute__((address_space(3)))
typedef unsigned short bf16;
typedef unsigned v4u __attribute__((ext_vector_type(4)));
typedef unsigned v2u __attribute__((ext_vector_type(2)));
typedef float f32x4 __attribute__((ext_vector_type(4)));
typedef float f32x16 __attribute__((ext_vector_type(16)));
typedef short bf16x8 __attribute__((ext_vector_type(8)));
typedef short s16x4 __attribute__((ext_vector_type(4)));
typedef GAS unsigned gu32;
#define RLX_AGENT __ATOMIC_RELAXED, __HIP_MEMORY_SCOPE_AGENT
#define LDS_WAIT() asm volatile("s_waitcnt lgkmcnt(0)" ::: "memory")
#define VM_WAIT() asm volatile("s_waitcnt vmcnt(0)" ::: "memory")
__device__ __forceinline__ unsigned f2bf(float f) { unsigned u = __builtin_bit_cast(unsigned, f); return (u + 0x7fffu + ((u >> 16) & 1u)) >> 16; }
__device__ __forceinline__ unsigned pk2(float lo, float hi) { return pg8::cvt_pk_bf16(lo, hi); }
__device__ __forceinline__ float clamp8(float x) { return __builtin_amdgcn_fmed3f(x, -448.f, 448.f); }
__device__ __forceinline__ unsigned pk4f8(float a, float b, float c, float d) { int p = __builtin_amdgcn_cvt_pk_fp8_f32(clamp8(a), clamp8(b), 0, false); p = __builtin_amdgcn_cvt_pk_fp8_f32(clamp8(c), clamp8(d), p, true); return (unsigned)p; }
__device__ __forceinline__ float bf_lo(unsigned u) { return __builtin_bit_cast(float, u << 16); }
__device__ __forceinline__ float bf_hi(unsigned u) { return __builtin_bit_cast(float, u & 0xffff0000u); }
__device__ __forceinline__ float sigmoidf_(float x) { return __builtin_amdgcn_rcpf(1.f + __builtin_amdgcn_exp2f(-x * LOG2E)); }
__device__ __forceinline__ float wave_sum(float v) {
#pragma unroll
    for (int o = 1; o < 64; o <<= 1) v += __shfl_xor(v, o);
    return v;
}

#define XB_TMO      128
#define XB_XCNT(j)  (256  + 64 * (j))
#define XB_XSUB(j)  (1280 + 64 * (j))
#define XB_XGEN(j)  (2304 + 64 * (j))
#define XB_TOP      3328
#define XB_TOPGEN   3392
#define XCD_BAR_WORDS 3456
#define XB_SPIN_CAP (1u << 18)

__device__ __forceinline__ unsigned xb_ld(unsigned* p)              { return __hip_atomic_load(p, __ATOMIC_RELAXED, __HIP_MEMORY_SCOPE_AGENT); }
__device__ __forceinline__ unsigned xb_add(unsigned* p, unsigned v) { return __hip_atomic_fetch_add(p, v, __ATOMIC_RELAXED, __HIP_MEMORY_SCOPE_AGENT); }
__device__ __forceinline__ unsigned xb_xcc_id() { return (unsigned)__builtin_amdgcn_s_getreg((3 << 11) | 20) & 0xFu; }
#define XB_SPIN(cond, bar) do { unsigned _sp = 0; while (cond) { __builtin_amdgcn_s_sleep(1); \
    if ((++_sp & 255u) == 0u) { if (xb_ld(&(bar)[XB_TMO])) break; if (_sp > XB_SPIN_CAP) { atomicAdd(&(bar)[XB_TMO], 1u); break; } } } } while (0)

struct XcdBarrier {
    unsigned* bar; unsigned x;
    volatile LAS unsigned* st;
};

__device__ __forceinline__ XcdBarrier xcd_barrier_post(unsigned* bar, volatile LAS unsigned* st) {
    XcdBarrier b; b.bar = bar; b.x = xb_xcc_id(); b.st = st;
    if (threadIdx.x == 0) (void)xb_add(&bar[XB_XCNT(b.x)], 1u);
    return b;
}
__device__ __forceinline__ void xcd_barrier_complete(unsigned* bar, unsigned x, unsigned& nloc, unsigned& nx) {
    const unsigned G = gridDim.x * gridDim.y * gridDim.z;
    unsigned sum, cnt, mine, sp = 0u;
    for (;;) {
        sum = 0u; cnt = 0u; mine = 0u;
#pragma unroll
        for (unsigned j = 0; j < 16; ++j) { const unsigned c = xb_ld(&bar[XB_XCNT(j)]); sum += c; cnt += (c > 0u) ? 1u : 0u; mine = (j == x) ? c : mine; }
        if (sum == G) break;
        __builtin_amdgcn_s_sleep(1);
        if ((++sp & 255u) == 0u) { if (xb_ld(&bar[XB_TMO])) break; if (sp > XB_SPIN_CAP) { atomicAdd(&bar[XB_TMO], 1u); break; } }
    }
    nloc = mine > 0u ? mine : 1u; nx = cnt > 0u ? cnt : 1u;
}

__device__ __forceinline__ void xcd_barrier(const XcdBarrier& b) {
    asm volatile("s_waitcnt vmcnt(0)" ::: "memory");
    __syncthreads();
    if (threadIdx.x == 0) {
        unsigned* bar = b.bar;
        __builtin_amdgcn_s_waitcnt(0);
        unsigned nloc = b.st[0], nx = b.st[1];
        if (nloc == 0u) { xcd_barrier_complete(bar, b.x, nloc, nx); b.st[0] = nloc; b.st[1] = nx; }
        const unsigned old = xb_add(&bar[XB_XSUB(b.x)], 1u);
        const unsigned gen = old / nloc;
        if (old + 1u == (gen + 1u) * nloc) {
            __builtin_amdgcn_fence(__ATOMIC_RELEASE, "agent");
            asm volatile("s_waitcnt vmcnt(0)" ::: "memory");
            const unsigned og = xb_add(&bar[XB_TOP], 1u);
            const unsigned tg = og / nx;
            if (og + 1u == (tg + 1u) * nx) xb_add(&bar[XB_TOPGEN], 1u);
            else XB_SPIN(xb_ld(&bar[XB_TOPGEN]) == tg, bar);
            __builtin_amdgcn_fence(__ATOMIC_ACQUIRE, "agent");
            xb_add(&bar[XB_XGEN(b.x)], 1u);
            asm volatile("s_waitcnt vmcnt(0)" ::: "memory");
        } else {
            XB_SPIN(xb_ld(&bar[XB_XGEN(b.x)]) == gen, bar);
            __builtin_amdgcn_fence(__ATOMIC_ACQUIRE, "agent");
            asm volatile("s_waitcnt vmcnt(0)" ::: "memory");
        }
    }
    __syncthreads();
}
namespace epi {
using pg8::Unit; using pg8::f32x4;
__device__ __forceinline__ void st8(bf16* p, const float* v) { v4u w; w.x = pk2(v[0], v[1]); w.y = pk2(v[2], v[3]); w.z = pk2(v[4], v[5]); w.w = pk2(v[6], v[7]); *(v4u*)p = w; }
__device__ __forceinline__ void ld8(const bf16* p, float* v) { const v4u w = *(const v4u*)p; v[0] = bf_lo(w.x); v[1] = bf_hi(w.x); v[2] = bf_lo(w.y); v[3] = bf_hi(w.y); v[4] = bf_lo(w.z); v[5] = bf_hi(w.z); v[6] = bf_lo(w.w); v[7] = bf_hi(w.w); }

__device__ __forceinline__ v4u widen16(v2u a, v2u b) {
    const auto r0 = __builtin_amdgcn_permlane16_swap(a.x, b.x, false, false), r1 = __builtin_amdgcn_permlane16_swap(a.y, b.y, false, false);
    return (v4u){(unsigned)r0[0], (unsigned)r1[0], (unsigned)r0[1], (unsigned)r1[1]};
}

struct NoPre {};
struct InProj {
    static constexpr int NSTORES = 0;
    static constexpr bool MMA0 = true;
    static constexpr bool PERM = true; typedef NoPre Pre; static constexpr bool HAS_MID = false; __device__ __forceinline__ void prefetch(Pre&, const Unit&, int, int, int, int, PG8_LAS unsigned char*) const {}
    bf16* Qc; bf16* Qr; bf16* KV6; bf16* F3; bf16* G2; float* SG; const float* CS; const float* fbias;
    template <int KIND>
    __device__ __forceinline__ void half(const f32x4 (&acc)[2][2][4][2], int bj, int rowb, bf16* dst, int ldd, bf16* dst2, int wc, int fr, int fq) const {
        int cw = wc * 32 + 8 * fq; asm volatile("" : "+v"(cw));
        const bool ropeW = (KIND <= 1) && ((wc & 1) == 0);
        f32x4 cc[4]; unsigned cso = (unsigned)rowb * 64u; asm volatile("" : "+v"(cso));
        if (KIND <= 1) { { const float* cp = (const float*)((const char*)CS + cso); cc[0] = *(const f32x4*)cp;     cc[1] = *(const f32x4*)(cp + 4); cc[2] = *(const f32x4*)(cp + 8); cc[3] = *(const f32x4*)(cp + 12); } }
        f32x4 fb0 = {0.f, 0.f, 0.f, 0.f}, fb1 = fb0;
        if (KIND == 5) { if (wc == 0 && fq == 3) { fb0 = *(const f32x4*)fbias; fb1 = *(const f32x4*)(fbias + 4); } }
#pragma unroll
        for (int ai = 0; ai < 2; ++ai)
#pragma unroll
            for (int m = 0; m < 4; ++m) {
                const int row = rowb + ai * 128 + m * 16;
                const int g_ = ai * 4 + m;
                float v[8];
#pragma unroll
                for (int j = 0; j < 4; ++j) { v[j] = acc[ai][bj][m][0][j]; v[4 + j] = acc[ai][bj][m][1][j]; }
                if (KIND == 0 || KIND == 3) {
#pragma unroll
                    for (int j = 0; j < 8; ++j) v[j] *= QSCALE;
                }
                if (KIND == 4) {
#pragma unroll
                    for (int j = 0; j < 8; ++j) v[j] = sigmoidf_(v[j]);
                }
                if (KIND == 5) {
                    if (wc == 0) {
                        float o[8];
                        if (fq < 3) {
#pragma unroll
                            for (int j = 0; j < 8; ++j) o[j] = sigmoidf_(v[j]);
                        } else {
#pragma unroll
                            for (int j = 0; j < 8; ++j) { const float x = v[j] + (j < 4 ? fb0[j & 3] : fb1[j & 3]); o[j] = -__builtin_amdgcn_logf(1.f + __builtin_amdgcn_exp2f(-x * LOG2E)); }
                        }
                        *(f32x4*)(SG + (size_t)row * 32 + cw) = (f32x4){o[0], o[1], o[2], o[3]};
                        *(f32x4*)(SG + (size_t)row * 32 + cw + 4) = (f32x4){o[4], o[5], o[6], o[7]};
                    }
                    continue;
                }
                if (KIND <= 1) {
                    float r[8];
#pragma unroll
                    for (int j = 0; j < 8; ++j) r[j] = v[j];
                    if (ropeW) {
                        const f32x4 c0 = cc[0], c1 = cc[1], s0 = cc[2], s1 = cc[3];
                        const float cs_[8] = {c0[0], c0[1], c0[2], c0[3], c1[0], c1[1], c1[2], c1[3]};
                        const float sn_[8] = {s0[0], s0[1], s0[2], s0[3], s1[0], s1[1], s1[2], s1[3]};
#pragma unroll
                        for (int j = 0; j < 8; ++j) {
                            const float w = __shfl_xor(v[j], 16);
                            const float ro = (fq == 0) ? (v[j] * cs_[j] - w * sn_[j]) : (v[j] * cs_[j] + w * sn_[j]);
                            r[j] = (fq < 2) ? ro : v[j];
                        }
                    }
                    asm volatile("" : "+v"(r[0]), "+v"(r[1]), "+v"(r[2]), "+v"(r[3]), "+v"(r[4]), "+v"(r[5]), "+v"(r[6]), "+v"(r[7]));
                    if (g_ < 7) { const float* cp = (const float*)((const char*)CS + (cso + (unsigned)((((g_ + 1) >> 2) * 128 + ((g_ + 1) & 3) * 16) * 64)));
                        cc[0] = *(const f32x4*)cp; cc[1] = *(const f32x4*)(cp + 4); cc[2] = *(const f32x4*)(cp + 8); cc[3] = *(const f32x4*)(cp + 12); }
                    if (KIND == 0) st8(dst + (size_t)row * ldd + cw, v);
                    st8((KIND == 0 ? dst2 : dst) + (size_t)row * ldd + cw, r);
                } else st8(dst + (size_t)row * ldd + cw, v);
            }
    }
    __device__ __forceinline__ void operator()(const f32x4 (&acc)[2][2][4][2], const Unit& u, int wr, int wc, int fr, int fq, const Pre& pre, PG8_LAS unsigned char* side) const {
        int rowb = u.pm * 256 + wr * 64 + fr; asm volatile("" : "+v"(rowb));
#pragma unroll
        for (int bj = 0; bj < 2; ++bj) {
            const int U = u.pn * 2 + bj;
            if (U < 4) half<0>(acc, bj, rowb, Qc + U * 128, 512, Qr + U * 128, wc, fr, fq);
            else if (U == 6 || U == 8) half<1>(acc, bj, rowb, KV6 + (size_t)(U - 4) * T * 128, 128, nullptr, wc, fr, fq);
            else if (U < 10) half<2>(acc, bj, rowb, KV6 + (size_t)(U - 4) * T * 128, 128, nullptr, wc, fr, fq);
            else if (U < 14) half<3>(acc, bj, rowb, F3 + (U - 10) * 128, 512, nullptr, wc, fr, fq);
            else if (U < 22) half<2>(acc, bj, rowb, F3 + (size_t)((U - 10) >> 2) * T * 512 + ((U - 10) & 3) * 128, 512, nullptr, wc, fr, fq);
            else if (U < 38) half<4>(acc, bj, rowb, G2 + (size_t)((U - 22) >> 3) * T * 1024 + ((U - 22) & 7) * 128, 1024, nullptr, wc, fr, fq);
            else if (U == 38) half<5>(acc, bj, rowb, nullptr, 0, nullptr, wc, fr, fq);
        }
    }
};

struct Gate1 {
    static constexpr int NSTORES = 0;
    static constexpr bool MMA0 = false;
    static constexpr bool PERM = true; typedef NoPre Pre; static constexpr bool HAS_MID = false; __device__ __forceinline__ void prefetch(Pre&, const Unit&, int, int, int, int, PG8_LAS unsigned char*) const {}
    const bf16* GN; bf16* TMP;
    __device__ __forceinline__ void operator()(const f32x4 (&acc)[2][2][4][2], const Unit& u, int wr, int wc, int fr, int fq, const Pre& pre, PG8_LAS unsigned char* side) const {
#pragma unroll
        for (int ai = 0; ai < 2; ++ai)
#pragma unroll
            for (int m = 0; m < 4; ++m) {
                const int row = u.pm * 256 + ai * 128 + wr * 64 + m * 16 + fr;
#pragma unroll
                for (int bj = 0; bj < 2; ++bj) {
                    const size_t off = (size_t)row * 1024 + u.pn * 256 + bj * 128 + wc * 32 + 8 * fq;
                    float g[8], v[8]; ld8(GN + off, g);
#pragma unroll
                    for (int j = 0; j < 4; ++j) { v[j] = acc[ai][bj][m][0][j] * g[j]; v[4 + j] = acc[ai][bj][m][1][j] * g[4 + j]; }
                    st8(TMP + off, v);
                }
            }
    }
};
struct Gate2 {
    static constexpr int NSTORES = 0;
    static constexpr bool MMA0 = false;
    static constexpr bool PERM = true; typedef NoPre Pre; static constexpr bool HAS_MID = false; __device__ __forceinline__ void prefetch(Pre&, const Unit&, int, int, int, int, PG8_LAS unsigned char*) const {}
    const bf16* GF; const bf16* TMP; bf16* MX;
    __device__ __forceinline__ void operator()(const f32x4 (&acc)[2][2][4][2], const Unit& u, int wr, int wc, int fr, int fq, const Pre& pre, PG8_LAS unsigned char* side) const {
#pragma unroll
        for (int ai = 0; ai < 2; ++ai)
#pragma unroll
            for (int m = 0; m < 4; ++m) {
                const int row = u.pm * 256 + ai * 128 + wr * 64 + m * 16 + fr;
#pragma unroll
                for (int bj = 0; bj < 2; ++bj) {
                    const size_t off = (size_t)row * 1024 + u.pn * 256 + bj * 128 + wc * 32 + 8 * fq;
                    float g[8], t[8], v[8]; ld8(GF + off, g); ld8(TMP + off, t);
#pragma unroll
                    for (int j = 0; j < 4; ++j) { v[j] = t[j] + acc[ai][bj][m][0][j] * g[j]; v[4 + j] = t[4 + j] + acc[ai][bj][m][1][j] * g[4 + j]; }
                    st8(MX + off, v);
                }
            }
    }
};
struct GateMix {
    static constexpr int NSTORES = 0;
    static constexpr bool MMA0 = true;
    static constexpr bool PERM = true; static constexpr bool HAS_MID = true; typedef NoPre Pre;
    const bf16* GN; const bf16* GF; bf16* MX;
    __device__ __forceinline__ void prefetch(Pre&, const Unit&, int, int, int, int, PG8_LAS unsigned char*) const {}
    __device__ __forceinline__ void mid(f32x4 (&acc)[2][2][4][2], const Unit& u, int wr, int wc, int fr, int fq) const {
        int opq = 0; asm volatile("" : "+v"(opq));
#pragma unroll
        for (int ai = 0; ai < 2; ++ai)
#pragma unroll
            for (int m = 0; m < 4; ++m) {
                const int row = u.pm * 256 + ai * 128 + wr * 64 + m * 16 + fr + opq;
#pragma unroll
                for (int bj = 0; bj < 2; ++bj) {
                    const size_t off = (size_t)row * 1024 + u.pn * 256 + bj * 128 + wc * 32 + 8 * fq;
                    float a[8], b[8]; ld8(GN + off, a); ld8(GF + off, b);
#pragma unroll
                    for (int j = 0; j < 4; ++j) { acc[ai][bj][m][0][j] *= a[j] * __builtin_amdgcn_rcpf(b[j]); acc[ai][bj][m][1][j] *= a[4 + j] * __builtin_amdgcn_rcpf(b[4 + j]); }
                }
                asm volatile("" ::: "memory");
            }
    }
    __device__ __forceinline__ void operator()(const f32x4 (&acc)[2][2][4][2], const Unit& u, int wr, int wc, int fr, int fq, const Pre&, PG8_LAS unsigned char* side) const {
        const size_t off0 = (size_t)(u.pm * 256 + wr * 64 + fr) * 1024 + u.pn * 256 + wc * 32 + 8 * fq;
        v4u gg[2][4][2];
#pragma unroll
        for (int ai = 0; ai < 2; ++ai)
#pragma unroll
            for (int m = 0; m < 4; ++m)
#pragma unroll
                for (int bj = 0; bj < 2; ++bj) gg[ai][m][bj] = *(const v4u*)(GF + off0 + (size_t)(ai * 128 + m * 16) * 1024 + bj * 128);
#pragma unroll
        for (int ai = 0; ai < 2; ++ai)
#pragma unroll
            for (int m = 0; m < 4; ++m)
#pragma unroll
                for (int bj = 0; bj < 2; ++bj) { const v4u w = gg[ai][m][bj];
                    const float b[8] = {bf_lo(w.x), bf_hi(w.x), bf_lo(w.y), bf_hi(w.y), bf_lo(w.z), bf_hi(w.z), bf_lo(w.w), bf_hi(w.w)}; float v[8];
#pragma unroll
                    for (int j = 0; j < 4; ++j) { v[j] = acc[ai][bj][m][0][j] * b[j]; v[4 + j] = acc[ai][bj][m][1][j] * b[4 + j]; }
                    st8(MX + off0 + (size_t)(ai * 128 + m * 16) * 1024 + bj * 128, v); }
    }
};
struct ResOut {
    static constexpr int NSTORES = 0;
    static constexpr bool MMA0 = true;
    static constexpr bool PERM = true; typedef NoPre Pre; static constexpr bool HAS_MID = false; __device__ __forceinline__ void prefetch(Pre&, const Unit&, int, int, int, int, PG8_LAS unsigned char*) const {}
    const float* X; bf16* X1;
    __device__ __forceinline__ void operator()(const f32x4 (&acc)[2][2][4][2], const Unit& u, int wr, int wc, int fr, int fq, const Pre& pre, PG8_LAS unsigned char* side) const {
#pragma unroll
        for (int bj = 0; bj < 2; ++bj) {
            const size_t off0 = (size_t)(u.pm * 256 + wr * 64 + fr) * 1024 + u.pn * 256 + bj * 128 + wc * 32 + 8 * fq;
            f32x4 xx[2][4][2];
#pragma unroll
            for (int ai = 0; ai < 2; ++ai)
#pragma unroll
                for (int m = 0; m < 4; ++m) { const size_t off = off0 + (size_t)(ai * 128 + m * 16) * 1024; xx[ai][m][0] = *(const f32x4*)(X + off); xx[ai][m][1] = *(const f32x4*)(X + off + 4); }
#pragma unroll
            for (int ai = 0; ai < 2; ++ai)
#pragma unroll
                for (int m = 0; m < 4; ++m) { const size_t off = off0 + (size_t)(ai * 128 + m * 16) * 1024;
                    float v[8];
#pragma unroll
                    for (int j = 0; j < 4; ++j) { v[j] = xx[ai][m][0][j] + acc[ai][bj][m][0][j]; v[4 + j] = xx[ai][m][1][j] + acc[ai][bj][m][1][j]; }
                    st8(X1 + off, v); }
        }
    }
};
struct Moe1 {
    static constexpr int NSTORES = 4;
    static constexpr bool MMA0 = true;
    static constexpr bool PERM = true; static constexpr bool HAS_MID = false; typedef NoPre Pre;
    __device__ __forceinline__ void prefetch(Pre&, const Unit& u, int wc, int fq, int wid, int lane, PG8_LAS unsigned char* side) const {
        if (wid == 0) { const int e = u.pn >> 3, ct = u.pn & 7; const float* src = b1 + (size_t)e * 2048 + (lane >> 5) * 1024 + ct * 128 + (lane & 31) * 4;
            __builtin_amdgcn_global_load_lds((const unsigned*)src, (PG8_LAS unsigned*)side, 16, 0, 0); } }
    const float* b1; unsigned char* ACT;
    __device__ __forceinline__ void operator()(const f32x4 (&acc)[2][2][4][2], const Unit& u, int wr, int wc, int fr, int fq, const Pre& pre, PG8_LAS unsigned char* side) const {
        const int e = u.pn >> 3, ct = u.pn & 7, cw = ct * 128 + wc * 32 + 8 * fq;
        const PG8_LAS float* sb = (const PG8_LAS float*)side + wc * 32 + 8 * fq;
        const f32x4 g0 = *(const PG8_LAS f32x4*)sb, g1 = *(const PG8_LAS f32x4*)(sb + 4), u0 = *(const PG8_LAS f32x4*)(sb + 128), u1 = *(const PG8_LAS f32x4*)(sb + 132);
        const int rsel = (fq & 1) * 16, cw16 = ct * 128 + wc * 32 + 16 * (fq >> 1);
#pragma unroll
        for (int ai = 0; ai < 2; ++ai)
#pragma unroll
            for (int mp = 0; mp < 2; ++mp) {
                v2u w[2];
#pragma unroll
                for (int mm = 0; mm < 2; ++mm) { const int m = 2 * mp + mm;
                    typedef float f2 __attribute__((ext_vector_type(2)));
                    f2 r_[4];
#pragma unroll
                    for (int q = 0; q < 4; ++q) {
                        const f32x4 ag = acc[ai][0][m][q >> 1], au = acc[ai][1][m][q >> 1], bg = (q >> 1) ? g1 : g0, bu = (q >> 1) ? u1 : u0;
                        const f2 ga = ((q & 1) ? __builtin_shufflevector(ag, ag, 2, 3) : __builtin_shufflevector(ag, ag, 0, 1)) + ((q & 1) ? __builtin_shufflevector(bg, bg, 2, 3) : __builtin_shufflevector(bg, bg, 0, 1));
                        const f2 ua = ((q & 1) ? __builtin_shufflevector(au, au, 2, 3) : __builtin_shufflevector(au, au, 0, 1)) + ((q & 1) ? __builtin_shufflevector(bu, bu, 2, 3) : __builtin_shufflevector(bu, bu, 0, 1));
                        const f2 gt = {fminf(ga.x, 7.0f), fminf(ga.y, 7.0f)};
                        const f2 up = {__builtin_amdgcn_fmed3f(ua.x, -7.0f, 7.0f), __builtin_amdgcn_fmed3f(ua.y, -7.0f, 7.0f)};
                        const f2 ea = gt * (-1.702f * LOG2E);
                        const f2 dn = (f2){__builtin_amdgcn_exp2f(ea.x), __builtin_amdgcn_exp2f(ea.y)} + 1.0f;
                        const f2 rc = {__builtin_amdgcn_rcpf(dn.x), __builtin_amdgcn_rcpf(dn.y)};
                        r_[q] = (up * 4.0f + 4.0f) * gt * rc;
                    }
                    int p0 = __builtin_amdgcn_cvt_pk_fp8_f32(r_[0].x, r_[0].y, 0, false); p0 = __builtin_amdgcn_cvt_pk_fp8_f32(r_[1].x, r_[1].y, p0, true);
                    int p1 = __builtin_amdgcn_cvt_pk_fp8_f32(r_[2].x, r_[2].y, 0, false); p1 = __builtin_amdgcn_cvt_pk_fp8_f32(r_[3].x, r_[3].y, p1, true);
                    w[mm].x = (unsigned)p0; w[mm].y = (unsigned)p1; }
                const int row = u.pm * 256 + ai * 128 + wr * 64 + mp * 32 + rsel + fr;
                *(v4u*)(ACT + (size_t)row * 1024 + cw16) = widen16(w[0], w[1]);
            }
    }
};
struct Moe2 {
    static constexpr int NSTORES = 8;
    static constexpr bool MMA0 = true;
    static constexpr bool PERM = true; static constexpr bool HAS_MID = false; typedef NoPre Pre;
    __device__ __forceinline__ void prefetch(Pre&, const Unit& u, int wc, int fq, int wid, int lane, PG8_LAS unsigned char* side) const {
        if (wid == 0) { const int e = u.pn >> 2, ct = u.pn & 3; __builtin_amdgcn_global_load_lds((const unsigned*)(b2 + (size_t)e * 1024 + ct * 256 + lane * 4), (PG8_LAS unsigned*)side, 16, 0, 0); }
        if (wid == 1) { __builtin_amdgcn_global_load_lds((const unsigned*)(SW + (size_t)u.pm * 256 + lane * 4), (PG8_LAS unsigned*)(side + 1024), 16, 0, 0); } }
    const float* b2; const float* SW; unsigned char* Y8;
    __device__ __forceinline__ void operator()(const f32x4 (&acc)[2][2][4][2], const Unit& u, int wr, int wc, int fr, int fq, const Pre& pre, PG8_LAS unsigned char* side) const {
        const int e = u.pn >> 2, ct = u.pn & 3;
#pragma unroll
        for (int bj = 0; bj < 2; ++bj) {
            const int col = ct * 256 + bj * 128 + wc * 32 + 8 * fq;
            const PG8_LAS float* sb = (const PG8_LAS float*)side + bj * 128 + wc * 32 + 8 * fq;
            const f32x4 c0 = *(const PG8_LAS f32x4*)sb, c1 = *(const PG8_LAS f32x4*)(sb + 4);
            const int rsel = (fq & 1) * 16, col16 = ct * 256 + bj * 128 + wc * 32 + 16 * (fq >> 1);
#pragma unroll
            for (int ai = 0; ai < 2; ++ai)
#pragma unroll
                for (int mp = 0; mp < 2; ++mp) {
                    v2u w8[2];
#pragma unroll
                    for (int mm = 0; mm < 2; ++mm) { const int m = 2 * mp + mm;
                        const float w = 16.f * ((const PG8_LAS float*)(side + 1024))[ai * 128 + wr * 64 + m * 16 + fr];
                        float v[8];
#pragma unroll
                        for (int j = 0; j < 4; ++j) { v[j] = (acc[ai][bj][m][0][j] + c0[j]) * w; v[4 + j] = (acc[ai][bj][m][1][j] + c1[j]) * w; }
                        w8[mm].x = pk4f8(v[0], v[1], v[2], v[3]); w8[mm].y = pk4f8(v[4], v[5], v[6], v[7]); }
                    const int row = u.pm * 256 + ai * 128 + wr * 64 + mp * 32 + rsel + fr;
                    *(v4u*)(Y8 + (size_t)row * 1024 + col16) = widen16(w8[0], w8[1]);
                }
        }
    }
};
}

namespace att {
constexpr int LK = 0, LV = 16384, LCK = 32768, LWS = 33280, LOST = 35328, LIMP = 68096, LDS_ATT = 76288;
__device__ __forceinline__ int crow(int r, int hi) { return (r & 3) + 8 * (r >> 2) + 4 * hi; }
__device__ __forceinline__ float xhalf_max(float m) { auto rr = __builtin_amdgcn_permlane32_swap(__float_as_uint(m), __float_as_uint(m), false, false); return fmaxf(__uint_as_float(rr[0]), __uint_as_float(rr[1])); }
__device__ __forceinline__ float xhalf_sum(float m) { auto rr = __builtin_amdgcn_permlane32_swap(__float_as_uint(m), __float_as_uint(m), false, false); return __uint_as_float(rr[0]) + __uint_as_float(rr[1]); }
typedef short v4i16_t __attribute__((ext_vector_type(4)));
__device__ __forceinline__ s16x4 vtr(const LAS char* p) { return __builtin_bit_cast(s16x4, __builtin_amdgcn_ds_read_tr16_b64_v4i16((LAS v4i16_t*)p)); }

__device__ __forceinline__ float max3f_(float a, float b, float c) { float r; asm("v_max3_f32 %0, %1, %2, %3" : "=v"(r) : "v"(a), "v"(b), "v"(c)); return r; }
__device__ __forceinline__ float quad_xor1(float x) { return __uint_as_float(__builtin_amdgcn_update_dpp(0u, __float_as_uint(x), 0xB1, 0xF, 0xF, false)); }
__device__ __forceinline__ float quad_xor2(float x) { return __uint_as_float(__builtin_amdgcn_update_dpp(0u, __float_as_uint(x), 0x4E, 0xF, 0xF, false)); }
__device__ __forceinline__ float xhalf_get(float x) { auto rr = __builtin_amdgcn_permlane32_swap(__float_as_uint(x), __float_as_uint(x), false, false); return __uint_as_float((threadIdx.x & 32) ? rr[0] : rr[1]); }
struct Ptrs {
    unsigned char* ws;
    __device__ __forceinline__ const bf16* Qc() const { return (const bf16*)(ws + WS_QC); }
    __device__ __forceinline__ const bf16* Qr() const { return (const bf16*)(ws + WS_QR); }
    __device__ __forceinline__ const bf16* KV6() const { return (const bf16*)(ws + WS_KV6); }
    __device__ __forceinline__ const bf16* F3() const { return (const bf16*)(ws + WS_F3); }
    __device__ __forceinline__ const float* C2() const { return (const float*)(ws + WS_C2); }
    __device__ __forceinline__ const float* SN() const { return (const float*)(ws + WS_SN); }
    __device__ __forceinline__ unsigned* SELM() const { return (unsigned*)(ws + WS_SELM); }
    __device__ __forceinline__ const float* SG() const { return (const float*)(ws + WS_SG); }
    __device__ __forceinline__ const bf16* KCMP() const { return (const bf16*)(ws + WS_KCMP); }
    __device__ __forceinline__ const bf16* VCMP() const { return (const bf16*)(ws + WS_VCMP); }
    __device__ __forceinline__ bf16* OC() const { return (bf16*)(ws + WS_OC); }
    __device__ __forceinline__ bf16* OW() const { return (bf16*)(ws + WS_OW); }
    __device__ __forceinline__ bf16* AO() const { return (bf16*)(ws + WS_AO); }
};

__device__ __forceinline__ void qkt(f32x16& p0, f32x16& p1, const LAS char* Kb, const bf16x8* qr, int r32, int hi, const f32x16& init) {
    const LAS char* kb = Kb + hi * 1024 + r32 * 16;
    p0 = init; p1 = init;
#pragma unroll
    for (int d0 = 0; d0 < 4; ++d0) {
        const bf16x8 b0 = *(const LAS bf16x8*)(kb + d0 * 2048);
        const bf16x8 b1 = *(const LAS bf16x8*)(kb + d0 * 2048 + 512);
        p0 = __builtin_amdgcn_mfma_f32_32x32x16_bf16(b0, qr[d0], p0, 0, 0, 0);
        p1 = __builtin_amdgcn_mfma_f32_32x32x16_bf16(b1, qr[d0], p1, 0, 0, 0);
    }
}
__device__ __forceinline__ void pv(f32x16* o, const LAS char* vb, const f32x16& p0, const f32x16& p1) {
    v4u pw[4];
#pragma unroll
    for (int i = 0; i < 4; ++i) { pw[0][i] = pk2(p0[2 * i], p0[2 * i + 1]); pw[1][i] = pk2(p0[8 + 2 * i], p0[9 + 2 * i]); pw[2][i] = pk2(p1[2 * i], p1[2 * i + 1]); pw[3][i] = pk2(p1[8 + 2 * i], p1[9 + 2 * i]); }
#pragma unroll
    for (int d0 = 0; d0 < 2; ++d0)
#pragma unroll
        for (int ks = 0; ks < 4; ++ks) {
            const s16x4 lo = vtr(vb + d0 * 4096 + ks * 1024), hh = vtr(vb + d0 * 4096 + ks * 1024 + 512);
            const bf16x8 vf = (bf16x8){lo[0], lo[1], lo[2], lo[3], hh[0], hh[1], hh[2], hh[3]};
            o[d0] = __builtin_amdgcn_mfma_f32_32x32x16_bf16(__builtin_bit_cast(bf16x8, pw[ks]), vf, o[d0], 0, 0, 0);
        }
}
__device__ __forceinline__ void stage_o(const f32x16* o, float l_part, LAS char* lds, int wid, int r32, int hi) {
    LAS float* wsf = (LAS float*)(lds + LWS) + wid * 64;
    const float l = xhalf_sum(l_part);
    if (hi == 0) wsf[32 + r32] = l;
    LDS_WAIT();
    LAS bf16* stg = (LAS bf16*)(lds + LOST) + wid * 2048;
#pragma unroll
    for (int r = 0; r < 16; ++r) {
        const float lr = wsf[32 + crow(r, hi)]; const float inv = lr > 0.f ? __builtin_amdgcn_rcpf(lr) : 0.f; const int orow = crow(r, hi);
        stg[orow * 64 + r32] = (bf16)f2bf(o[0][r] * inv); stg[orow * 64 + 32 + r32] = (bf16)f2bf(o[1][r] * inv);
    }
    LDS_WAIT();
}

template <int MODE>
__device__ __forceinline__ void attn_unit(int b, int h, int qb, const Ptrs& P, LAS char* lds) {
    const int tid = threadIdx.x, lane = tid & 63, r32 = lane & 31, hi = lane >> 5; const int wid = __builtin_amdgcn_readfirstlane(tid >> 6);
    const size_t rowbase = (size_t)b * SEQ; const int q0 = qb * 256, qw0 = q0 + wid * 32, qpos = qw0 + r32;
    const bf16* Qp; const bf16 *Kp, *Vp; int kvp;
    if (MODE == 0) { Qp = P.F3() + (rowbase * 512 + h * 64); Kp = P.F3() + (size_t)T * 512 + (rowbase * 512 + h * 64); Vp = P.F3() + (size_t)2 * T * 512 + (rowbase * 512 + h * 64); kvp = 512; }
    else { const int g = h >> 2; const int ti = (MODE == 1) ? 4 : 2; Qp = P.Qr() + (rowbase * 512 + h * 64);
        Kp = P.KV6() + (size_t)ti * T * 128 + (rowbase * 128 + g * 64); Vp = P.KV6() + (size_t)(ti + 1) * T * 128 + (rowbase * 128 + g * 64); kvp = 128; }
    bf16x8 qr[4];
#pragma unroll
    for (int d0 = 0; d0 < 4; ++d0) qr[d0] = *(const bf16x8*)(Qp + (size_t)qpos * 512 + d0 * 16 + hi * 8);
    float c2q = 0.f; unsigned sm = 0u; const float* c2p = nullptr;
    if (MODE == 0) { c2p = P.C2() + (size_t)(b * 8 + h) * SEQ; c2q = c2p[qpos]; }
    if (MODE == 2) sm = P.SELM()[(size_t)(b * 2 + (h >> 2)) * SEQ + qpos];
    asm volatile("" : "+v"(qr[0]), "+v"(qr[1]), "+v"(qr[2]), "+v"(qr[3]), "+v"(c2q), "+v"(sm));
    int t0 = (MODE == 1) ? (4 * qb - 8 > 0 ? 4 * qb - 8 : 0) : 0; const int t1 = 4 * qb + 4;
    float prune_c = 0.f;
    if (MODE == 0) {
        const float smax = sqrtf(P.SN()[b * 8 + h] * P.SN()[128 + b * 8 + h]);
        const float cq0 = c2p[q0];
        const float ce = c2p[64 * r32 + 63];
        const unsigned long long keep = __ballot(cq0 - ce + 2.f * smax >= -50.f);
        const int first = keep ? (int)__builtin_ctzll(keep) : 0;
        t0 = __builtin_amdgcn_readfirstlane(first < 4 * qb ? first : 4 * qb);
        prune_c = 2.f * smax + 50.f + c2p[qw0];
    }
    const bf16* ksrc = Kp + (size_t)lane * kvp + wid * 8;
    const bf16* vsrc = Vp + (size_t)(16 * (wid & 3) + (lane >> 2)) * kvp + (wid >> 2) * 32 + (lane & 3) * 8;
    const int sdst = wid * 1024 + lane * 16;
    v4u kreg, vreg; float ckreg = 0.f;
    kreg = *(const v4u*)(ksrc + (size_t)t0 * 64 * kvp); vreg = *(const v4u*)(vsrc + (size_t)t0 * 64 * kvp);
    if (MODE == 0 && tid < 64) ckreg = c2p[t0 * 64 + tid];
    __syncthreads();
    *(LAS v4u*)(lds + LK + sdst) = kreg; *(LAS v4u*)(lds + LV + sdst) = vreg;
    if (MODE == 0 && tid < 64) ((LAS float*)(lds + LCK))[tid] = ckreg;
    __syncthreads();
    float mref = 0.f, l = 0.f; f32x16 o[2]; o[0] = f32x16{}; o[1] = f32x16{}; f32x16 negm = f32x16{};
    LAS float* wsf = (LAS float*)(lds + LWS) + wid * 64;
    const int vboff = ((lane >> 4) & 1) * 32 + (lane & 3) * 8 + (4 * hi + ((lane & 15) >> 2)) * 64;
    for (int t = t0; t < t1; ++t) {
        const int cur = (t - t0) & 1;
        if (t + 1 < t1) {
            kreg = *(const v4u*)(ksrc + (size_t)(t + 1) * 64 * kvp); vreg = *(const v4u*)(vsrc + (size_t)(t + 1) * 64 * kvp);
            if (MODE == 0 && tid < 64) ckreg = c2p[(t + 1) * 64 + tid];
        }
        const int kv0 = t * 64;
        bool active = kv0 <= qw0 + 31;
        if (MODE == 1) active = active && (kv0 + 63 > qw0 - 512);
        if (MODE == 0) active = active && (__builtin_amdgcn_readfirstlane(__float_as_uint(prune_c - ((const LAS float*)(lds + LCK + cur * 256))[63])) >> 31) == 0u;
        if (active) {
            f32x16 p0, p1;
            qkt(p0, p1, lds + LK + cur * 8192, qr, r32, hi, negm);
            if (MODE == 0) {
                const LAS float* ck = (const LAS float*)(lds + LCK + cur * 256);
#pragma unroll
                for (int g4 = 0; g4 < 4; ++g4) {
                    const f32x4 a = *(const LAS f32x4*)(ck + 8 * g4 + 4 * hi), bb = *(const LAS f32x4*)(ck + 32 + 8 * g4 + 4 * hi);
#pragma unroll
                    for (int j = 0; j < 4; ++j) { p0[4 * g4 + j] += c2q - a[j]; p1[4 * g4 + j] += c2q - bb[j]; }
                }
            }
            const bool diag = (kv0 + 63 > qw0) || (MODE == 1 && kv0 <= qw0 + 31 - 512);
            if (diag) {
                const bool blk = (MODE == 2) ? ((sm >> t) & 1u) != 0u : true;
#pragma unroll
                for (int r = 0; r < 16; ++r) {
                    const int ka = kv0 + crow(r, hi), kb = ka + 32;
                    bool va = blk && ka <= qpos, vb = blk && kb <= qpos;
                    if (MODE == 1) { va = va && ka > qpos - 512; vb = vb && kb > qpos - 512; }
                    p0[r] = va ? p0[r] : -INFINITY; p1[r] = vb ? p1[r] : -INFINITY;
                }
            } else if (MODE == 2) {
                const bool blk = ((sm >> t) & 1u) != 0u;
#pragma unroll
                for (int r = 0; r < 16; ++r) { p0[r] = blk ? p0[r] : -INFINITY; p1[r] = blk ? p1[r] : -INFINITY; }
            }
            float mx = fmaxf(p0[0], p1[0]);
#pragma unroll
            for (int r = 1; r < 16; ++r) mx = fmaxf(mx, fmaxf(p0[r], p1[r]));
            mx = xhalf_max(mx);
            if (__any(mx > 8.f)) {
                const float dl = fmaxf(mx, 0.f), alpha = __builtin_amdgcn_exp2f(-dl);
                mref += dl; l *= alpha;
#pragma unroll
                for (int r = 0; r < 16; ++r) { p0[r] -= dl; p1[r] -= dl; negm[r] = -mref; }
                if (hi == 0) wsf[r32] = alpha;
                LDS_WAIT();
#pragma unroll
                for (int g4 = 0; g4 < 4; ++g4) {
                    const f32x4 a = *(const LAS f32x4*)(wsf + 8 * g4 + 4 * hi);
#pragma unroll
                    for (int j = 0; j < 4; ++j) { o[0][4 * g4 + j] *= a[j]; o[1][4 * g4 + j] *= a[j]; }
                }
            }
            float s0 = 0.f, s1 = 0.f, s2 = 0.f, s3 = 0.f;
#pragma unroll
            for (int r = 0; r < 16; r += 2) { p0[r] = __builtin_amdgcn_exp2f(p0[r]); p1[r] = __builtin_amdgcn_exp2f(p1[r]); p0[r + 1] = __builtin_amdgcn_exp2f(p0[r + 1]); p1[r + 1] = __builtin_amdgcn_exp2f(p1[r + 1]);
                s0 += p0[r]; s1 += p1[r]; s2 += p0[r + 1]; s3 += p1[r + 1]; }
            l += (s0 + s1) + (s2 + s3);
            pv(o, lds + LV + cur * 8192 + vboff, p0, p1);
        }
        if (t + 1 < t1) {
            *(LAS v4u*)(lds + LK + (cur ^ 1) * 8192 + sdst) = kreg; *(LAS v4u*)(lds + LV + (cur ^ 1) * 8192 + sdst) = vreg;
            if (MODE == 0 && tid < 64) ((LAS float*)(lds + LCK + (cur ^ 1) * 256))[tid] = ckreg;
        }
        __syncthreads();
    }
    stage_o(o, l, lds, wid, r32, hi);
    const LAS bf16* stg = (const LAS bf16*)(lds + LOST) + wid * 2048;
#pragma unroll
    for (int i = 0; i < 4; ++i) {
        const int row = i * 8 + (lane >> 3), ch = lane & 7; const size_t grow = rowbase + qw0 + row;
        const v4u v = *(const LAS v4u*)(stg + row * 64 + ch * 8);
        if (MODE == 0) *(v4u*)(P.AO() + grow * 1024 + 512 + h * 64 + ch * 8) = v;
        else if (MODE == 1) *(v4u*)(P.OW() + grow * 512 + h * 64 + ch * 8) = v;
        else {
            const float g0 = P.SG()[grow * 32 + h * 3 + 0], g1 = P.SG()[grow * 32 + h * 3 + 1], g2 = P.SG()[grow * 32 + h * 3 + 2];
            const v4u vc = *(const v4u*)(P.OC() + grow * 512 + h * 64 + ch * 8), vw = *(const v4u*)(P.OW() + grow * 512 + h * 64 + ch * 8);
            v4u out;
#pragma unroll
            for (int j = 0; j < 4; ++j) {
                const float lo = g0 * bf_lo(vc[j]) + g1 * bf_lo(v[j]) + g2 * bf_lo(vw[j]);
                const float hh = g0 * bf_hi(vc[j]) + g1 * bf_hi(v[j]) + g2 * bf_hi(vw[j]);
                out[j] = pk2(lo, hh);
            }
            *(v4u*)(P.AO() + grow * 1024 + h * 64 + ch * 8) = out;
        }
    }
}

__device__ __forceinline__ void cmp_unit(int b, int g, int qblk, const Ptrs& P, LAS char* lds) {
    const int tid = threadIdx.x, lane = tid & 63, r32 = lane & 31, hi = lane >> 5; const int wid = __builtin_amdgcn_readfirstlane(tid >> 6);
    const size_t rowbase = (size_t)b * SEQ; const int s0 = qblk * 64, tok = s0 + 8 * wid + (r32 >> 2), head = 4 * g + (r32 & 3);
    bf16x8 qr[4];
#pragma unroll
    for (int d0 = 0; d0 < 4; ++d0) qr[d0] = *(const bf16x8*)(P.Qc() + (rowbase + tok) * 512 + head * 64 + d0 * 16 + hi * 8);
    const bf16* Kc = P.KCMP() + (size_t)(b * 2 + g) * 128 * 64; const bf16* Vc = P.VCMP() + (size_t)(b * 2 + g) * 128 * 64;
    __syncthreads();
#pragma unroll
    for (int tt = 0; tt < 2; ++tt) {
        const v4u kreg = *(const v4u*)(Kc + (size_t)(tt * 64 + lane) * 64 + wid * 8);
        const v4u vreg = *(const v4u*)(Vc + (size_t)(tt * 64 + 16 * (wid & 3) + (lane >> 2)) * 64 + (wid >> 2) * 32 + (lane & 3) * 8);
        *(LAS v4u*)(lds + LK + tt * 8192 + wid * 1024 + lane * 16) = kreg; *(LAS v4u*)(lds + LV + tt * 8192 + wid * 1024 + lane * 16) = vreg;
    }
    __syncthreads();
    const int nvalid = tok >= 31 ? ((tok - 31) / 16 + 1 < 127 ? (tok - 31) / 16 + 1 : 127) : 0;
    f32x16 p[4];
    { const f32x16 z16 = f32x16{}; qkt(p[0], p[1], lds + LK, qr, r32, hi, z16); qkt(p[2], p[3], lds + LK + 8192, qr, r32, hi, z16); }
#pragma unroll
    for (int tq = 0; tq < 4; ++tq)
#pragma unroll
        for (int r = 0; r < 16; ++r) { const int c = 32 * tq + crow(r, hi); p[tq][r] = c < nvalid ? p[tq][r] : -INFINITY; }
    float mxa = -INFINITY, mxb = -INFINITY;
#pragma unroll
    for (int tq = 0; tq < 4; ++tq)
#pragma unroll
        for (int r = 0; r < 16; r += 4) { mxa = max3f_(mxa, p[tq][r], p[tq][r + 1]); mxb = max3f_(mxb, p[tq][r + 2], p[tq][r + 3]); }
    float mx = max3f_(mxa, mxb, mxb);
    mx = xhalf_max(mx); if (nvalid == 0) mx = 0.f;
    float s = 0.f;
#pragma unroll
    for (int tq = 0; tq < 4; ++tq)
#pragma unroll
        for (int r = 0; r < 16; ++r) { p[tq][r] = __builtin_amdgcn_exp2f(p[tq][r] - mx); s += p[tq][r]; }
    s = xhalf_sum(s);
    const float inv = nvalid > 0 ? 1.f / s : 0.f;
#pragma unroll
    for (int tq = 0; tq < 4; ++tq)
#pragma unroll
        for (int r = 0; r < 16; ++r) p[tq][r] *= inv;
    float imp[16];
    {
        float glast[16];
#pragma unroll
        for (int tq = 0; tq < 4; ++tq)
#pragma unroll
            for (int g4 = 0; g4 < 4; ++g4) { imp[4 * tq + g4] = (p[tq][4 * g4] + p[tq][4 * g4 + 1]) + (p[tq][4 * g4 + 2] + p[tq][4 * g4 + 3]); glast[4 * tq + g4] = p[tq][4 * g4 + 3]; }
        float prev = 0.f;
#pragma unroll
        for (int k = 0; k < 16; ++k) { const float pl = xhalf_get(glast[k]); imp[k] += hi ? pl : prev; prev = pl; }
#pragma unroll
        for (int k = 0; k < 16; ++k) { imp[k] += quad_xor1(imp[k]); imp[k] += quad_xor2(imp[k]); }
    }
    LAS float* impl = (LAS float*)(lds + LIMP) + wid * 256;
    if ((r32 & 3) == 0) {
#pragma unroll
        for (int k = 0; k < 16; ++k) impl[(r32 >> 2) * 32 + 2 * k + hi] = imp[k];
    }
    f32x16 o[2]; o[0] = f32x16{}; o[1] = f32x16{};
    const int vboff = ((lane >> 4) & 1) * 32 + (lane & 3) * 8 + (4 * hi + ((lane & 15) >> 2)) * 64;
    pv(o, lds + LV + vboff, p[0], p[1]); pv(o, lds + LV + 8192 + vboff, p[2], p[3]);
    {
        LAS bf16* stg = (LAS bf16*)(lds + LOST) + wid * 2048;
#pragma unroll
        for (int r = 0; r < 16; ++r) { const int orow = crow(r, hi); stg[orow * 64 + r32] = (bf16)f2bf(o[0][r]); stg[orow * 64 + 32 + r32] = (bf16)f2bf(o[1][r]); }
        LDS_WAIT();
#pragma unroll
        for (int i = 0; i < 4; ++i) {
            const int row = i * 8 + (lane >> 3), ch = lane & 7;
            const v4u v = *(const LAS v4u*)(stg + row * 64 + ch * 8);
            *(v4u*)(P.OC() + (rowbase + s0 + 8 * wid + (row >> 2)) * 512 + (4 * g + (row & 3)) * 64 + ch * 8) = v;
        }
    }
    LDS_WAIT();
    {
        const int ti = lane >> 3, jq = lane & 7, tk = s0 + 8 * wid + ti; const int curb = qblk;
        const int nforced = 1 + (curb >= 1) + (curb >= 2);
        unsigned long long keyj[4];
#pragma unroll
        for (int jj = 0; jj < 4; ++jj) { const int jx = 4 * jq + jj; keyj[jj] = ((unsigned long long)__float_as_uint(impl[ti * 32 + jx]) << 5) | (unsigned)(31 - jx); }
        int rank[4] = {0, 0, 0, 0};
        for (int k = 1; k <= curb - 2; ++k) {
            const unsigned long long keyk = ((unsigned long long)__float_as_uint(impl[ti * 32 + k]) << 5) | (unsigned)(31 - k);
#pragma unroll
            for (int jj = 0; jj < 4; ++jj) rank[jj] += keyk > keyj[jj] ? 1 : 0;
        }
        unsigned bits = 0u;
#pragma unroll
        for (int jj = 0; jj < 4; ++jj) {
            const int jx = 4 * jq + jj;
            const bool forced = (jx == 0) || (jx == curb) || (jx == curb - 1);
            const bool valid = jx <= curb;
            const bool sel = forced ? valid : (valid && rank[jj] < 8 - nforced);
            bits |= sel ? (1u << jx) : 0u;
        }
        bits |= __shfl_xor(bits, 1); bits |= __shfl_xor(bits, 2); bits |= __shfl_xor(bits, 4);
        if (jq == 0) P.SELM()[(size_t)(b * 2 + g) * SEQ + tk] = bits;
    }
}
}

namespace att {
constexpr int L2K = 0, L2V = 32768, L2CK = 65536, L2WS = 66560, L2OST = 68608, L2END = 101376;

__device__ __forceinline__ float max3f(float a, float b, float c) { float r; asm("v_max3_f32 %0, %1, %2, %3" : "=v"(r) : "v"(a), "v"(b), "v"(c)); return r; }
#define MAX2(a_, b_) max3f((a_), (b_), (b_))
#define ATT2_SOFTMAX(P0, P1, O_, MREF, L_, C2Q, SM_, QPOS, QBASE, INI_) do { \
        const bool diag_ = (kv0 + 63 > (QBASE)) || (MODE == 1 && kv0 <= (QBASE) + 31 - 512); \
        if (diag_) { const bool blk = true; \
            int dq = (QPOS) - kv0 - 4 * hi; asm volatile("" : "+v"(dq));     \
            _Pragma("unroll") for (int r = 0; r < 16; ++r) { const int c_r = (r & 3) + 8 * (r >> 2); bool va = blk && c_r <= dq, vb = blk && c_r + 32 <= dq; \
                if (MODE == 1) { va = va && c_r > dq - 512; vb = vb && c_r + 32 > dq - 512; } P0[r] = va ? P0[r] : -INFINITY; P1[r] = vb ? P1[r] : -INFINITY; } } \
        if (MODE != 0 && !diag_) asm volatile("s_nop 15\n\ts_nop 7" : "+v"(P0), "+v"(P1));     \
        float mxa = max3f(P0[0], P1[0], P0[1]), mxb = max3f(P1[1], P0[2], P1[2]); \
        _Pragma("unroll") for (int r = 3; r < 15; r += 2) { mxa = max3f(mxa, P0[r], P1[r]); mxb = max3f(mxb, P0[r + 1], P1[r + 1]); } \
        float mx = max3f(mxa, mxb, max3f(P0[15], P1[15], P0[15])); \
        { auto rr_ = __builtin_amdgcn_permlane32_swap(__float_as_uint(mx), __float_as_uint(mx), false, false); mx = max3f(__uint_as_float(rr_[0]), __uint_as_float(rr_[1]), __uint_as_float(rr_[1])); } \
        if (__any(mx > 8.f)) { const float dl = MAX2(mx, 0.f), alpha = __builtin_amdgcn_exp2f(-dl); MREF += dl; L_ *= alpha; \
            if (MODE != 2 && (QBASE) == qw0) { const float nv_ = (MODE == 0) ? (C2Q) - MREF : -MREF; _Pragma("unroll") for (int r = 0; r < 16; ++r) INI_[r] = nv_; }     \
            _Pragma("unroll") for (int r = 0; r < 16; ++r) { P0[r] -= dl; P1[r] -= dl; } \
            if (hi == 0) wsf[r32] = alpha; LDS_WAIT(); \
            _Pragma("unroll") for (int g4 = 0; g4 < 4; ++g4) { const f32x4 a = *(const LAS f32x4*)(wsf + 8 * g4 + 4 * hi); \
                _Pragma("unroll") for (int j = 0; j < 4; ++j) { O_[0][4 * g4 + j] *= a[j]; O_[1][4 * g4 + j] *= a[j]; } } \
            LDS_WAIT(); } \
        float s0 = 0.f, s1 = 0.f, s2 = 0.f, s3 = 0.f; \
        _Pragma("unroll") for (int r = 0; r < 16; r += 2) { P0[r] = __builtin_amdgcn_exp2f(P0[r]); P1[r] = __builtin_amdgcn_exp2f(P1[r]); P0[r + 1] = __builtin_amdgcn_exp2f(P0[r + 1]); P1[r + 1] = __builtin_amdgcn_exp2f(P1[r + 1]); \
            s0 += P0[r]; s1 += P1[r]; s2 += P0[r + 1]; s3 += P1[r + 1]; } \
        L_ += (s0 + s1) + (s2 + s3); } while (0)

template <int MODE>
__device__ __forceinline__ void attn_unit2(int b, int hp, int qb, const Ptrs& P, LAS char* lds) {
    int tid = threadIdx.x; asm volatile("" : "+v"(tid));
    const int lane = tid & 63, r32 = lane & 31, hi = lane >> 5; const int wid = __builtin_amdgcn_readfirstlane(tid >> 6), sub = wid >> 2, w4 = wid & 3;
    const int h = 2 * hp + sub;
    const size_t rowbase = (size_t)b * SEQ; const int q0 = qb * 256, qw0 = q0 + w4 * 64, qposA = qw0 + r32, qposB = qposA + 32;
    const bf16* Qp = (MODE == 0) ? P.F3() + (rowbase * 512 + h * 64) : P.Qr() + (rowbase * 512 + h * 64);
    bf16x8 qrA[4], qrB[4];
#pragma unroll
    for (int d0 = 0; d0 < 4; ++d0) { qrA[d0] = *(const bf16x8*)(Qp + (size_t)qposA * 512 + d0 * 16 + hi * 8); qrB[d0] = *(const bf16x8*)(Qp + (size_t)qposB * 512 + d0 * 16 + hi * 8); }
    float c2qA = 0.f, c2qB = 0.f; unsigned smA = 0u, smB = 0u; const float* c2p = nullptr;
    if (MODE == 0) { c2p = P.C2() + (size_t)(b * 8 + h) * SEQ; c2qA = c2p[qposA]; c2qB = c2p[qposB]; }
    if (MODE == 2) { const unsigned* sp = P.SELM() + (size_t)(b * 2 + (hp >> 1)) * SEQ; smA = sp[qposA]; smB = sp[qposB]; }
    asm volatile("" : "+v"(qrA[0]), "+v"(qrA[1]), "+v"(qrA[2]), "+v"(qrA[3]), "+v"(qrB[0]), "+v"(qrB[1]), "+v"(qrB[2]), "+v"(qrB[3]), "+v"(c2qA), "+v"(c2qB), "+v"(smA), "+v"(smB));
    int t0 = (MODE == 1) ? (4 * qb - 8 > 0 ? 4 * qb - 8 : 0) : 0; const int t1 = 4 * qb + 4;
    float prune_c = 0.f;
    if (MODE == 0) {
        int first2 = 64;
#pragma unroll
        for (int s_ = 0; s_ < 2; ++s_) { const int hh_ = 2 * hp + s_; const float* cp = P.C2() + (size_t)(b * 8 + hh_) * SEQ;
            const float smax = sqrtf(P.SN()[b * 8 + hh_] * P.SN()[128 + b * 8 + hh_]);
            const unsigned long long keep = __ballot(cp[q0] - cp[64 * r32 + 63] + 2.f * smax >= -50.f);
            const int first = keep ? (int)__builtin_ctzll(keep) : 0; first2 = first < first2 ? first : first2;
            if (s_ == sub) prune_c = 2.f * smax + 50.f + cp[qw0]; }
        t0 = __builtin_amdgcn_readfirstlane(first2 < 4 * qb ? first2 : 4 * qb);
    }
    const bf16 *kbase, *vbase; int kvp, np, pk0, sslot;
    if (MODE == 0) { const int hs = 2 * hp + sub; kbase = P.F3() + (size_t)T * 512 + (rowbase * 512 + hs * 64); vbase = P.F3() + (size_t)2 * T * 512 + (rowbase * 512 + hs * 64); kvp = 512; np = 2; sslot = sub; pk0 = w4; }
    else { const int g = hp >> 1; const int ti = (MODE == 1) ? 4 : 2; kbase = P.KV6() + (size_t)ti * T * 128 + (rowbase * 128 + g * 64); vbase = P.KV6() + (size_t)(ti + 1) * T * 128 + (rowbase * 128 + g * 64); kvp = 128; np = 1; sslot = 0; pk0 = wid; }
    const bf16* ksrc = kbase + (size_t)lane * kvp + pk0 * 8; const bf16* vsrc = vbase + (size_t)(16 * (pk0 & 3) + (lane >> 2)) * kvp + (pk0 >> 2) * 32 + (lane & 3) * 8;
    const int sbase = sslot * 8192 + pk0 * 1024;
    const int myslot = (MODE == 0) ? sub : 0;
#define ATT2_DMA(T_, ST_) do { _Pragma("unroll") for (int i = 0; i < 2; ++i) if (i < np) { \
            __builtin_amdgcn_global_load_lds((const unsigned*)(ksrc + (size_t)(T_) * 64 * kvp + 32 * i), (LAS unsigned*)(lds + L2K + (ST_) * 16384 + sbase + 4096 * i), 16, 0, 0); \
            __builtin_amdgcn_global_load_lds((const unsigned*)(vsrc + (size_t)(T_) * 64 * kvp + 32 * i), (LAS unsigned*)(lds + L2V + (ST_) * 16384 + sbase + 4096 * i), 16, 0, 0); } \
        if (MODE == 0 && wid < 2) __builtin_amdgcn_global_load_lds((const unsigned*)(P.C2() + (size_t)(b * 8 + 2 * hp + wid) * SEQ + (T_) * 64 + lane), (LAS unsigned*)(lds + L2CK + (ST_) * 512 + wid * 256), 4, 0, 0); } while (0)
#define ATT2_LANDED() do { asm volatile("s_waitcnt vmcnt(0)" ::: "memory"); __syncthreads(); } while (0)
    __syncthreads();
    ATT2_DMA(t0, 0);
    ATT2_LANDED();
    float mrefA = 0.f, lA = 0.f, mrefB = 0.f, lB = 0.f; f32x16 oA[2], oB[2]; oA[0] = f32x16{}; oA[1] = f32x16{}; oB[0] = f32x16{}; oB[1] = f32x16{};
    f32x16 iniTA;
#pragma unroll
    for (int r = 0; r < 16; ++r) iniTA[r] = (MODE == 0) ? c2qA : 0.f;
    LAS float* wsf = (LAS float*)(lds + L2WS) + wid * 64;
    const int vboff = ((lane >> 4) & 1) * 32 + (lane & 3) * 8 + (4 * hi + ((lane & 15) >> 2)) * 64;
    for (int t = t0; t < t1; ++t) {
        const int cur = (t - t0) & 1;
        if (t + 1 < t1) ATT2_DMA(t + 1, cur ^ 1);
        const int kv0 = t * 64;
        const LAS float* ck = (const LAS float*)(lds + L2CK + cur * 512 + myslot * 256);
        bool active = kv0 <= qw0 + 63;
        if (MODE == 1) active = active && (kv0 + 63 > qw0 - 512);
        if (MODE == 0) active = active && (__builtin_amdgcn_readfirstlane(__float_as_uint(prune_c - ck[63])) >> 31) == 0u;
        if (MODE == 2) active = active && __any((int)(((smA | smB) >> t) & 1u));
        if (active) {
            const LAS char* kb = lds + L2K + cur * 16384 + myslot * 8192 + hi * 1024 + r32 * 16;
            f32x16 pa0, pa1, pb0, pb1;
            const float iniA = (MODE == 2 && ((smA >> t) & 1u) == 0u) ? -INFINITY : (MODE == 0 ? c2qA - mrefA : -mrefA), iniB = (MODE == 2 && ((smB >> t) & 1u) == 0u) ? -INFINITY : (MODE == 0 ? c2qB - mrefB : -mrefB);
            if (MODE == 2) {
#pragma unroll
                for (int r = 0; r < 16; ++r) { pa0[r] = iniA; pa1[r] = iniA; }
            }
#pragma unroll
            for (int r = 0; r < 16; ++r) { pb0[r] = iniB; pb1[r] = iniB; }
#pragma unroll
            for (int d0 = 0; d0 < 4; ++d0) {
                const bf16x8 k0 = *(const LAS bf16x8*)(kb + d0 * 2048), k1 = *(const LAS bf16x8*)(kb + d0 * 2048 + 512);
                if (MODE != 2 && d0 == 0) {
                    asm volatile("v_mfma_f32_32x32x16_bf16 %0, %2, %4, %5\n\tv_mfma_f32_32x32x16_bf16 %1, %3, %4, %5" : "=&v"(pa0), "=&v"(pa1) : "v"(k0), "v"(k1), "v"(qrA[0]), "v"(iniTA));
                } else {
                    pa0 = __builtin_amdgcn_mfma_f32_32x32x16_bf16(k0, qrA[d0], pa0, 0, 0, 0); pa1 = __builtin_amdgcn_mfma_f32_32x32x16_bf16(k1, qrA[d0], pa1, 0, 0, 0);
                }
                pb0 = __builtin_amdgcn_mfma_f32_32x32x16_bf16(k0, qrB[d0], pb0, 0, 0, 0); pb1 = __builtin_amdgcn_mfma_f32_32x32x16_bf16(k1, qrB[d0], pb1, 0, 0, 0);
            }
            if (MODE == 0) {
#pragma unroll
                for (int g4 = 0; g4 < 4; ++g4) { const f32x4 a = *(const LAS f32x4*)(ck + 8 * g4 + 4 * hi), bb = *(const LAS f32x4*)(ck + 32 + 8 * g4 + 4 * hi);
#pragma unroll
                    for (int j = 0; j < 4; ++j) { pa0[4 * g4 + j] -= a[j]; pa1[4 * g4 + j] -= bb[j]; pb0[4 * g4 + j] -= a[j]; pb1[4 * g4 + j] -= bb[j]; }
                    asm volatile("" ::: "memory"); }
            }
            ATT2_SOFTMAX(pa0, pa1, oA, mrefA, lA, c2qA, smA, qposA, qw0, iniTA);
            ATT2_SOFTMAX(pb0, pb1, oB, mrefB, lB, c2qB, smB, qposB, qw0 + 32, iniTA);
            v4u pwA[4], pwB[4];
#pragma unroll
            for (int i = 0; i < 4; ++i) { pwA[0][i] = pk2(pa0[2 * i], pa0[2 * i + 1]); pwA[1][i] = pk2(pa0[8 + 2 * i], pa0[9 + 2 * i]); pwA[2][i] = pk2(pa1[2 * i], pa1[2 * i + 1]); pwA[3][i] = pk2(pa1[8 + 2 * i], pa1[9 + 2 * i]);
                                          pwB[0][i] = pk2(pb0[2 * i], pb0[2 * i + 1]); pwB[1][i] = pk2(pb0[8 + 2 * i], pb0[9 + 2 * i]); pwB[2][i] = pk2(pb1[2 * i], pb1[2 * i + 1]); pwB[3][i] = pk2(pb1[8 + 2 * i], pb1[9 + 2 * i]); }
            const LAS char* vb = lds + L2V + cur * 16384 + myslot * 8192 + vboff;
#pragma unroll
            for (int d0 = 0; d0 < 2; ++d0)
#pragma unroll
                for (int ks = 0; ks < 4; ++ks) {
                    const s16x4 lo = vtr(vb + d0 * 4096 + ks * 1024), hh = vtr(vb + d0 * 4096 + ks * 1024 + 512);
                    const bf16x8 vf = (bf16x8){lo[0], lo[1], lo[2], lo[3], hh[0], hh[1], hh[2], hh[3]};
                    oA[d0] = __builtin_amdgcn_mfma_f32_32x32x16_bf16(__builtin_bit_cast(bf16x8, pwA[ks]), vf, oA[d0], 0, 0, 0);
                    oB[d0] = __builtin_amdgcn_mfma_f32_32x32x16_bf16(__builtin_bit_cast(bf16x8, pwB[ks]), vf, oB[d0], 0, 0, 0);
                }
        }
        ATT2_LANDED();
    }
#undef ATT2_DMA
#undef ATT2_LANDED
#pragma unroll
    for (int blk2 = 0; blk2 < 2; ++blk2) {
        const f32x16* o = blk2 ? oB : oA; const float l_part = blk2 ? lB : lA;
        const float l = xhalf_sum(l_part);
        if (hi == 0) wsf[32 + r32] = l;
        LDS_WAIT();
        LAS bf16* stg = (LAS bf16*)(lds + L2OST) + wid * 2048;
#pragma unroll
        for (int r = 0; r < 16; ++r) {
            const float lr = wsf[32 + crow(r, hi)]; const float inv = lr > 0.f ? __builtin_amdgcn_rcpf(lr) : 0.f; const int orow = crow(r, hi);
            stg[orow * 64 + r32] = (bf16)f2bf(o[0][r] * inv); stg[orow * 64 + 32 + r32] = (bf16)f2bf(o[1][r] * inv);
        }
        LDS_WAIT();
        if (MODE == 2) {
            float g0[4], g1[4], g2[4]; v4u vc[4], vw[4];
#pragma unroll
            for (int i = 0; i < 4; ++i) { const int row = i * 8 + (lane >> 3), ch = lane & 7; const size_t grow = rowbase + qw0 + blk2 * 32 + row;
                g0[i] = P.SG()[grow * 32 + h * 3 + 0]; g1[i] = P.SG()[grow * 32 + h * 3 + 1]; g2[i] = P.SG()[grow * 32 + h * 3 + 2];
                vc[i] = *(const v4u*)(P.OC() + grow * 512 + h * 64 + ch * 8); vw[i] = *(const v4u*)(P.OW() + grow * 512 + h * 64 + ch * 8); }
#pragma unroll
            for (int i = 0; i < 4; ++i) { const int row = i * 8 + (lane >> 3), ch = lane & 7; const size_t grow = rowbase + qw0 + blk2 * 32 + row;
                const v4u v = *(const LAS v4u*)(stg + row * 64 + ch * 8);
                v4u out;
#pragma unroll
                for (int j = 0; j < 4; ++j) {
                    const float lo = g0[i] * bf_lo(vc[i][j]) + g1[i] * bf_lo(v[j]) + g2[i] * bf_lo(vw[i][j]);
                    const float hh = g0[i] * bf_hi(vc[i][j]) + g1[i] * bf_hi(v[j]) + g2[i] * bf_hi(vw[i][j]);
                    out[j] = pk2(lo, hh);
                }
                *(v4u*)(P.AO() + grow * 1024 + h * 64 + ch * 8) = out; }
        } else {
#pragma unroll
            for (int i = 0; i < 4; ++i) {
                const int row = i * 8 + (lane >> 3), ch = lane & 7; const size_t grow = rowbase + qw0 + blk2 * 32 + row;
                const v4u v = *(const LAS v4u*)(stg + row * 64 + ch * 8);
                if (MODE == 0) *(v4u*)(P.AO() + grow * 1024 + 512 + h * 64 + ch * 8) = v;
                else *(v4u*)(P.OW() + grow * 512 + h * 64 + ch * 8) = v;
            }
        }
        LDS_WAIT();
    }
}
#undef ATT2_SOFTMAX
#undef MAX2
}

#ifndef MOE_ALIGN
#define MOE_ALIGN true
#endif

struct Args { const void* in[19]; float* out; unsigned char* ws; int ph_lo, ph_hi, rep_mask, pad; };
struct Frame {
    LAS unsigned char* lds; volatile LAS unsigned* MISC; gu32* ctl;
    int tid, lane, wave, vcu, G;
    unsigned char* ws;
};

template <class Map>
__device__ __forceinline__ void transpose_item(const float* W, int Nsrc, bf16* WT, int ldt, int koff, int k0, int n0, const Map& map4, LAS float* scr, int lane) {
    const int c = lane & 15, sc = map4(n0 + 4 * c);
    f32x4 v[16];
#pragma unroll
    for (int i = 0; i < 16; ++i) { const int kk = (lane >> 4) + 4 * i; v[i] = sc >= 0 ? *(const f32x4*)(W + (size_t)(k0 + kk) * Nsrc + sc) : (f32x4){0.f, 0.f, 0.f, 0.f}; }
#pragma unroll
    for (int i = 0; i < 16; ++i) { const int kk = (lane >> 4) + 4 * i;
#pragma unroll
        for (int j = 0; j < 4; ++j) scr[(4 * c + j) * 65 + kk] = v[i][j]; }
    LDS_WAIT(); asm volatile("" ::: "memory");
    const int ch = lane & 7;
#pragma unroll
    for (int jj = 0; jj < 8; ++jj) { const int n = (lane >> 3) + 8 * jj; const LAS float* s = scr + n * 65 + 8 * ch;
        v4u o; o.x = pk2(s[0], s[1]); o.y = pk2(s[2], s[3]); o.z = pk2(s[4], s[5]); o.w = pk2(s[6], s[7]);
        *(v4u*)(WT + (size_t)(n0 + n) * ldt + koff + k0 + 8 * ch) = o; }
    LDS_WAIT(); asm volatile("" ::: "memory");
}
template <class Map>
__device__ __forceinline__ void transpose_item_f8(const float* W, int Nsrc, unsigned char* WT8, int ldt, int koff, int k0, int n0, const Map& map4, LAS float* scr, int lane) {
    const int c = lane & 7, sc = map4(n0 + 4 * c);
    f32x4 v[16];
#pragma unroll
    for (int i = 0; i < 16; ++i) { const int kk = (lane >> 3) + 8 * i; v[i] = sc >= 0 ? __builtin_nontemporal_load((const f32x4*)(W + (size_t)(k0 + kk) * Nsrc + sc)) : (f32x4){0.f, 0.f, 0.f, 0.f}; }
#pragma unroll
    for (int i = 0; i < 16; ++i) { const int kk = (lane >> 3) + 8 * i;
#pragma unroll
        for (int j = 0; j < 4; ++j) scr[(4 * c + j) * 129 + kk] = v[i][j] * 64.0f; }
    LDS_WAIT(); asm volatile("" ::: "memory");
    const int ch = lane & 7;
#pragma unroll
    for (int jj = 0; jj < 4; ++jj) { const int n = (lane >> 3) + 8 * jj; const LAS float* s = scr + n * 129 + 16 * ch;
        v4u o; o.x = pk4f8(s[0], s[1], s[2], s[3]); o.y = pk4f8(s[4], s[5], s[6], s[7]); o.z = pk4f8(s[8], s[9], s[10], s[11]); o.w = pk4f8(s[12], s[13], s[14], s[15]);
        *(v4u*)(WT8 + (size_t)(n0 + n) * ldt + koff + k0 + 16 * ch) = o; }
    LDS_WAIT(); asm volatile("" ::: "memory");
}
struct MapId { __device__ __forceinline__ int operator()(int n) const { return n; } };
struct MapIn { __device__ __forceinline__ int operator()(int n) const { return n < 1280 ? n : n < 2816 ? n + 24 : n < 4864 ? n + 32 : n < 4888 ? 1280 + (n - 4864) : n < 4896 ? 2840 + (n - 4888) : -1; } };
struct MapW1 { __device__ __forceinline__ int operator()(int n) const { const int t = n >> 8, i = n & 255; return i < 128 ? 128 * t + i : 1024 + 128 * t + (i - 128); } };

constexpr int CONV_I1 = 8 * 64, CONV_I2 = 8 * 32, CONV_ITEMS = 32 * (CONV_I1 + CONV_I2);
__device__ __forceinline__ void expert_item(Frame& F, const Args& a, int r) {
    const float* ew1 = (const float*)a.in[14]; const float* ew2 = (const float*)a.in[16];
    unsigned char* W1 = F.ws + WS_W1; unsigned char* W2 = F.ws + WS_W2;
    LAS float* scr = (LAS float*)(F.lds + F.wave * 16640);
    if (r < 32 * CONV_I1) { const int e = r / CONV_I1, q = r % CONV_I1, kb = q / 64, nb = q % 64; transpose_item_f8(ew1 + (size_t)e * 1024 * 2048, 2048, W1 + (size_t)e * 2048 * 1024, 1024, 0, 128 * kb, 32 * nb, MapW1(), scr, F.lane); return; }
    r -= 32 * CONV_I1;
    { const int e = r / CONV_I2, q = r % CONV_I2, kb = q / 32, nb = q % 32; transpose_item_f8(ew2 + (size_t)e * 1024 * 1024, 1024, W2 + (size_t)e * 1024 * 1024, 1024, 0, 128 * kb, 32 * nb, MapId(), scr, F.lane); }
}
__device__ __forceinline__ void conv_drain(Frame& F, const Args& a, int watch_cw, int watch_n) {
    LAS int* qslot = (LAS int*)(F.lds + LDSCTL_OFF);
    for (;;) {
        __syncthreads();
        if (F.tid == 0) {
            int v = -1;
            if (watch_cw < 0 || (int)__hip_atomic_load((unsigned*)(F.ctl + watch_cw), RLX_AGENT) < watch_n) v = (int)__hip_atomic_fetch_add((unsigned*)(F.ctl + CW_QC), 1u, RLX_AGENT);
            qslot[0] = v;
        }
        __syncthreads();
        const int bt = qslot[0];
        if (bt < 0 || bt * 8 >= CONV_ITEMS) break;
        const int it = bt * 8 + F.wave;
        if (it < CONV_ITEMS) expert_item(F, a, it);
    }
    __syncthreads();
}
__device__ __forceinline__ void conv_one(Frame& F, const Args& a) {
    LAS int* qslot = (LAS int*)(F.lds + LDSCTL_OFF);
    __syncthreads();
    if (F.tid == 0) qslot[1] = (int)__hip_atomic_fetch_add((unsigned*)(F.ctl + CW_QC), 1u, RLX_AGENT);
    __syncthreads();
    const int it = qslot[1] * 8 + F.wave;
    if (it < CONV_ITEMS) expert_item(F, a, it);
}
__device__ __forceinline__ void p0_prologue(Frame& F, const Args& a) {
    const float* x = (const float*)a.in[0]; const int* pos = (const int*)a.in[1]; const float* g1 = (const float*)a.in[2]; const float* w_in = (const float*)a.in[3];
    const float* pe = (const float*)a.in[4]; const float* cw1 = (const float*)a.in[5];
    const float* wpn = (const float*)a.in[8]; const float* wpf = (const float*)a.in[9]; const float* wout = (const float*)a.in[10];
    const float* ew1 = (const float*)a.in[14]; const float* ew2 = (const float*)a.in[16];
    LAS float* scr = (LAS float*)(F.lds + F.wave * 16640);
    const int gw = F.vcu * NWAVES + F.wave, NGW = F.G * NWAVES;
    constexpr int I_IN = 8 * 160, I_P = 8 * 16, I_O = 16 * 16, I_1 = 8 * 64, I_2 = 8 * 32, I_C = 32;
    constexpr int NITEMS = I_IN + 2 * I_P + I_O + 32 * I_1 + 32 * I_2 + 2 * I_C;
    unsigned char* Win8 = F.ws + WS_WIN; bf16* Wp = (bf16*)(F.ws + WS_WP); bf16* Wo = (bf16*)(F.ws + WS_WOUT); unsigned char* W1 = F.ws + WS_W1; unsigned char* W2 = F.ws + WS_W2; bf16* W1c = (bf16*)(F.ws + WS_W1C);
#ifndef CONV_MOD
#define CONV_MOD 6
#endif
    for (int it = gw; it < NITEMS; it += NGW) {
        int r = it;
        if (CONV_MOD != 0 && r >= I_IN + 2 * I_P + I_O && r < I_IN + 2 * I_P + I_O + 32 * I_1 + 32 * I_2) continue;
        if (r < I_IN) { const int kb = r / 160, nb = r % 160; transpose_item_f8(w_in, IN_COLS, Win8, 1024, 0, 128 * kb, 32 * nb, MapIn(), scr, F.lane); continue; } r -= I_IN;
        if (r < I_P) { const int kb = r / 16, nb = r % 16; transpose_item(wpn, 1024, Wp, 1024, 0, 64 * kb, 64 * nb, MapId(), scr, F.lane); continue; } r -= I_P;
        if (r < I_P) { const int kb = r / 16, nb = r % 16; transpose_item(wpf, 1024, Wp, 1024, 512, 64 * kb, 64 * nb, MapId(), scr, F.lane); continue; } r -= I_P;
        if (r < I_O) { const int kb = r / 16, nb = r % 16; transpose_item(wout, 1024, Wo, 1024, 0, 64 * kb, 64 * nb, MapId(), scr, F.lane); continue; } r -= I_O;
        if (r < 32 * I_1) { const int e = r / I_1, q = r % I_1, kb = q / 64, nb = q % 64; transpose_item_f8(ew1 + (size_t)e * 1024 * 2048, 2048, W1 + (size_t)e * 2048 * 1024, 1024, 0, 128 * kb, 32 * nb, MapW1(), scr, F.lane); continue; } r -= 32 * I_1;
        if (r < 32 * I_2) { const int e = r / I_2, q = r % I_2, kb = q / 32, nb = q % 32; transpose_item_f8(ew2 + (size_t)e * 1024 * 1024, 1024, W2 + (size_t)e * 1024 * 1024, 1024, 0, 128 * kb, 32 * nb, MapId(), scr, F.lane); continue; } r -= 32 * I_2;
        { const int ts = r / I_C, kb = r % I_C; transpose_item(cw1 + (size_t)ts * 2048 * 64, 64, W1c + (size_t)ts * 64 * 2048, 2048, 0, 64 * kb, 0, MapId(), scr, F.lane); }
    }
    unsigned char* H8 = F.ws + WS_H;
    {
        f32x4 gv[4];
#pragma unroll
        for (int j = 0; j < 4; ++j) gv[j] = *((const f32x4*)g1 + F.lane + 64 * j);
        for (int m = gw; m < T; m += 2 * NGW) {
            const f32x4* xr0 = (const f32x4*)(x + (size_t)m * 1024) + F.lane; const f32x4* xr1 = (const f32x4*)(x + (size_t)(m + NGW) * 1024) + F.lane;
            f32x4 v[2][4]; float s0 = 0.f, s1 = 0.f;
#pragma unroll
            for (int j = 0; j < 4; ++j) { v[0][j] = xr0[64 * j]; v[1][j] = xr1[64 * j]; }
#pragma unroll
            for (int j = 0; j < 4; ++j) { s0 += (v[0][j].x * v[0][j].x + v[0][j].y * v[0][j].y) + (v[0][j].z * v[0][j].z + v[0][j].w * v[0][j].w);
                                          s1 += (v[1][j].x * v[1][j].x + v[1][j].y * v[1][j].y) + (v[1][j].z * v[1][j].z + v[1][j].w * v[1][j].w); }
            const float rs0 = 1.0f / sqrtf(wave_sum(s0) * (1.f / 1024.f) + NORM_EPS), rs1 = 1.0f / sqrtf(wave_sum(s1) * (1.f / 1024.f) + NORM_EPS);
            unsigned* o0 = (unsigned*)(H8 + (size_t)m * 1024) + F.lane; unsigned* o1 = (unsigned*)(H8 + (size_t)(m + NGW) * 1024) + F.lane;
#pragma unroll
            for (int j = 0; j < 4; ++j) { const f32x4 y0 = v[0][j] * (16.f * rs0) * gv[j], y1 = v[1][j] * (16.f * rs1) * gv[j];
                o0[64 * j] = pk4f8(y0.x, y0.y, y0.z, y0.w); o1[64 * j] = pk4f8(y1.x, y1.y, y1.z, y1.w); }
        }
    }
    {
        float* CS = (float*)(F.ws + WS_CS);
        for (int idx = (F.vcu * 512 + F.tid); idx < T * 8; idx += F.G * 512) {
            const int t = idx >> 3, i = idx & 7;
            const float freq = exp2f(-(float)i * 0.125f * 18.931568569324174f);
            const float ang = (float)pos[t] * freq;
            const float kq = rintf(ang * 0.15915494309189535f);
            float rem = fmaf(-kq, 6.28318548202514648f, ang); rem = fmaf(-kq, -1.74845553e-7f, rem);
            const float rev = rem * 0.15915494309189535f;
            CS[(size_t)t * 16 + i] = __builtin_amdgcn_cosf(rev); CS[(size_t)t * 16 + 8 + i] = __builtin_amdgcn_sinf(rev);
        }
    }
    {
        const float* g2 = (const float*)a.in[11]; const float* rw = (const float*)a.in[12]; unsigned* WB = (unsigned*)(F.ws + WS_WRB);
        for (int idx = F.vcu * 512 + F.tid; idx < 16384; idx += F.G * 512) {
            const int e = idx & 31, dp = idx >> 5;
            const float w0 = rw[(2 * dp) * 32 + e] * g2[2 * dp], w1 = rw[(2 * dp + 1) * 32 + e] * g2[2 * dp + 1];
            const unsigned ph = pk2(w0, w1); const unsigned pl = pk2(w0 - bf_lo(ph), w1 - bf_hi(ph));
            WB[e * 516 + dp] = ph; WB[16512 + e * 516 + dp] = pl;
        }
    }
    if (gw < 128) {
        const int ts = gw >> 6, n = gw & 63; float s = 0.f;
        for (int k = F.lane; k < 2048; k += 64) s += pe[(size_t)ts * 2048 + k] * cw1[((size_t)ts * 2048 + k) * 64 + n];
        s = wave_sum(s);
        if (F.lane == 0) ((float*)(F.ws + WS_CCONST))[gw] = s;
    }
}

__device__ __forceinline__ float gelu_tanh(float x) { const float u = 0.7978845608028654f * (x + 0.044715f * x * x * x); const float e = __builtin_amdgcn_exp2f(2.f * LOG2E * u); const float th = 1.f - 2.f * __builtin_amdgcn_rcpf(e + 1.f); return 0.5f * x * (1.f + th); }
__device__ __forceinline__ void p2_compress(Frame& F, const Args& a) {
    const float* cw2 = (const float*)a.in[6];
    const bf16* KV6 = (const bf16*)(F.ws + WS_KV6); const bf16* W1c = (const bf16*)(F.ws + WS_W1C); const float* cconst = (const float*)(F.ws + WS_CCONST);
    const int lane = F.lane, r32 = lane & 31, hi = lane >> 5, wave = F.wave;
    LAS float* red = (LAS float*)F.lds;
    LAS float* gb = (LAS float*)(F.lds + 65536);
    LAS float* w2s = (LAS float*)(F.lds + 65536 + 8192);
    for (int u = F.vcu; u < 256; u += F.G) {
        const int ts = u >> 7, b = (u >> 3) & 15, g = (u >> 2) & 1, cb = u & 3;
        const bf16* src = KV6 + (size_t)ts * T * 128; const bf16* Wt = W1c + (size_t)ts * 64 * 2048;
        const int c = 32 * cb + r32, cl = c < 126 ? c : 126;
        f32x16 a0 = f32x16{}, a1 = f32x16{};
#pragma unroll 4
        for (int k8 = 0; k8 < 16; ++k8) {
            const int ks = 16 * wave + k8, li = ks >> 2, d = 16 * (ks & 3) + 8 * hi;
            const bf16x8 af = *(const bf16x8*)(src + ((size_t)b * SEQ + 16 * cl + li) * 128 + g * 64 + d);
            const bf16x8 b0 = *(const bf16x8*)(Wt + (size_t)r32 * 2048 + 16 * ks + 8 * hi);
            const bf16x8 b1 = *(const bf16x8*)(Wt + (size_t)(r32 + 32) * 2048 + 16 * ks + 8 * hi);
            a0 = __builtin_amdgcn_mfma_f32_32x32x16_bf16(af, b0, a0, 0, 0, 0);
            a1 = __builtin_amdgcn_mfma_f32_32x32x16_bf16(af, b1, a1, 0, 0, 0);
        }
        __syncthreads();
        { const f32x4* w2g = (const f32x4*)(cw2 + (size_t)ts * 4096); ((LAS f32x4*)w2s)[F.tid] = w2g[F.tid]; ((LAS f32x4*)w2s)[F.tid + 512] = w2g[F.tid + 512]; }
#pragma unroll
        for (int r = 0; r < 16; ++r) { const int row = att::crow(r, hi); red[wave * 2048 + row * 64 + r32] = a0[r]; red[wave * 2048 + row * 64 + 32 + r32] = a1[r]; }
        __syncthreads();
#pragma unroll
        for (int q = 0; q < 4; ++q) { const int o = F.tid * 4 + q; float s = cconst[ts * 64 + (o & 63)];
#pragma unroll
            for (int w = 0; w < 8; ++w) s += red[w * 2048 + o];
            gb[o] = gelu_tanh(s); }
        __syncthreads();
        bf16* outp = (bf16*)(F.ws + (ts ? WS_VCMP : WS_KCMP)) + (size_t)(b * 2 + g) * 128 * 64;
        {
            const int row = F.tid >> 4, c4 = (F.tid & 15) * 4; f32x4 acc4 = (f32x4){0.f, 0.f, 0.f, 0.f};
#pragma unroll 8
            for (int n = 0; n < 64; ++n) { const float gv_ = gb[row * 64 + n]; const f32x4 w = *(const LAS f32x4*)(w2s + n * 64 + c4); acc4 += gv_ * w; }
            const int cc = 32 * cb + row;
            v2u w8; w8.x = cc < 127 ? pk2(acc4[0], acc4[1]) : 0u; w8.y = cc < 127 ? pk2(acc4[2], acc4[3]) : 0u;
            *(v2u*)(outp + (size_t)cc * 64 + c4) = w8;
        }
    }
    for (int task = F.vcu; task < 256; task += F.G) {
        const int which = task >> 7, bh = task & 127, b = bh >> 3, h = bh & 7;
        const bf16* src = (const bf16*)(F.ws + WS_F3) + (size_t)which * T * 512 + (size_t)b * SEQ * 512 + h * 64;
        float mx = 0.f;
#pragma unroll
        for (int i = 0; i < 4; ++i) { const int row = F.tid + 512 * i; float n2 = 0.f;
#pragma unroll
            for (int c8 = 0; c8 < 8; ++c8) { const v4u w = *(const v4u*)(src + (size_t)row * 512 + c8 * 8);
#pragma unroll
                for (int j = 0; j < 4; ++j) { const float lo = bf_lo(w[j]), hh = bf_hi(w[j]); n2 += lo * lo + hh * hh; } }
            mx = fmaxf(mx, n2); }
#pragma unroll
        for (int o = 1; o < 64; o <<= 1) mx = fmaxf(mx, __shfl_xor(mx, o));
        __syncthreads();
        if (lane == 0) red[wave] = mx;
        __syncthreads();
        if (F.tid == 0) { float r = red[0]; for (int w = 1; w < 8; ++w) r = fmaxf(r, red[w]); ((float*)(F.ws + WS_SN))[task] = r; }
    }
    for (int task = F.vcu; task < 128; task += F.G) {
        const int b = task >> 3, h = task & 7; const float* SG = (const float*)(F.ws + WS_SG); float* C2 = (float*)(F.ws + WS_C2) + (size_t)task * SEQ;
        float v[4]; float run = 0.f;
#pragma unroll
        for (int i = 0; i < 4; ++i) { run += SG[((size_t)b * SEQ + 4 * F.tid + i) * 32 + 24 + h]; v[i] = run; }
        float incl = run;
#pragma unroll
        for (int o = 1; o < 64; o <<= 1) { const float t = __shfl_up(incl, o); if (lane >= o) incl += t; }
        __syncthreads();
        if (lane == 63) red[wave] = incl;
        __syncthreads();
        float base = incl - run;
        for (int w = 0; w < wave; ++w) base += red[w];
        *(f32x4*)(C2 + 4 * F.tid) = (f32x4){v[0] + base, v[1] + base, v[2] + base, v[3] + base};
    }
}

constexpr int P7_WBROW = 2064, P7_WBHALF = 32 * P7_WBROW, P7_G2S = 2 * P7_WBHALF, P7_LG = P7_G2S + 4096, P7_HIST = P7_LG + 8 * 2112;
__device__ __forceinline__ void p7_route(Frame& F, const Args& a, int nrep) {
    const float* g2 = (const float*)a.in[11]; const float* rb = (const float*)a.in[13];
    const bf16* X1 = (const bf16*)(F.ws + WS_X1); unsigned char* H2 = F.ws + WS_H2;
    int* TOKE = (int*)(F.ws + WS_TOKE); float* TOKW = (float*)(F.ws + WS_TOKW);
    LAS unsigned* hist = (LAS unsigned*)(F.lds + P7_HIST);
    LAS float* g2s = (LAS float*)(F.lds + P7_G2S);
    LAS float* LG = (LAS float*)(F.lds + P7_LG + F.wave * 2112);
    const int lane = F.lane, tok = lane & 15, g = lane >> 4, gw = F.vcu * NWAVES + F.wave, NGW = F.G * NWAVES, NT = T / 16;
    bf16x8 av[32];
#define P7_LOAD(tile_) { const bf16x8* xr_ = (const bf16x8*)(X1 + ((size_t)(tile_) * 16 + tok) * 1024) + 2 * g; \
        _Pragma("unroll") for (int kp = 0; kp < 16; ++kp) { av[2 * kp] = xr_[8 * kp]; av[2 * kp + 1] = xr_[8 * kp + 1]; } }
    for (int i = F.tid; i < 1024; i += 512) g2s[i] = 16.f * g2[i];
    for (int i = (int)blockIdx.x * 512 + F.tid; i < A_PAD; i += F.G * 512) ((int*)(F.ws + WS_SLOTT))[i] = 0;
    if (F.tid < 32) hist[F.tid] = 0u;
    {
        const v4u* src = (const v4u*)(F.ws + WS_WRB);
#pragma unroll 1
        for (int i0 = 0; i0 < 8192; i0 += 2048) { v4u t[4];
#pragma unroll
            for (int j = 0; j < 4; ++j) t[j] = src[i0 + j * 512 + F.tid];
#pragma unroll
            for (int j = 0; j < 4; ++j) *(LAS v4u*)(F.lds + 16 * (i0 + j * 512 + F.tid)) = t[j]; }
        if (F.tid < 64) *(LAS v4u*)(F.lds + 16 * (8192 + F.tid)) = src[8192 + F.tid];
    }
    __syncthreads();
    const float b0 = rb[tok], b1 = rb[16 + tok];
    const LAS unsigned char* bb = F.lds + tok * P7_WBROW + g * 32;
    for (int rep_ = 0; rep_ < nrep; ++rep_)
    for (int tile = gw; tile < NT; tile += NGW) {
        P7_LOAD(tile)
        f32x4 acc[4] = {{0.f, 0.f, 0.f, 0.f}, {0.f, 0.f, 0.f, 0.f}, {0.f, 0.f, 0.f, 0.f}, {0.f, 0.f, 0.f, 0.f}};
#define P7_BLOAD(ks_, h0_, h1_, l0_, l1_) { const int off_ = ((ks_) >> 1) * 128 + ((ks_) & 1) * 16; \
            h0_ = *(const LAS bf16x8*)(bb + off_); h1_ = *(const LAS bf16x8*)(bb + 16 * P7_WBROW + off_); l0_ = *(const LAS bf16x8*)(bb + P7_WBHALF + off_); l1_ = *(const LAS bf16x8*)(bb + P7_WBHALF + 16 * P7_WBROW + off_); }
        bf16x8 bq[2][4];
        P7_BLOAD(0, bq[0][0], bq[0][1], bq[0][2], bq[0][3])
#pragma unroll
        for (int ks = 0; ks < 32; ++ks) {
            if (ks + 1 < 32) P7_BLOAD(ks + 1, bq[(ks + 1) & 1][0], bq[(ks + 1) & 1][1], bq[(ks + 1) & 1][2], bq[(ks + 1) & 1][3])
            acc[0] = __builtin_amdgcn_mfma_f32_16x16x32_bf16(av[ks], bq[ks & 1][0], acc[0], 0, 0, 0);
            acc[1] = __builtin_amdgcn_mfma_f32_16x16x32_bf16(av[ks], bq[ks & 1][1], acc[1], 0, 0, 0);
            acc[2] = __builtin_amdgcn_mfma_f32_16x16x32_bf16(av[ks], bq[ks & 1][2], acc[2], 0, 0, 0);
            acc[3] = __builtin_amdgcn_mfma_f32_16x16x32_bf16(av[ks], bq[ks & 1][3], acc[3], 0, 0, 0);
            __builtin_amdgcn_sched_barrier(0);
        }
        float s0 = 0.f, s1 = 0.f, s2 = 0.f, s3 = 0.f;
#pragma unroll
        for (int i = 0; i < 32; ++i) { const v4u w = __builtin_bit_cast(v4u, av[i]);
            s0 = fmaf(bf_lo(w.x), bf_lo(w.x), s0); s1 = fmaf(bf_hi(w.x), bf_hi(w.x), s1); s2 = fmaf(bf_lo(w.y), bf_lo(w.y), s2); s3 = fmaf(bf_hi(w.y), bf_hi(w.y), s3);
            s0 = fmaf(bf_lo(w.z), bf_lo(w.z), s0); s1 = fmaf(bf_hi(w.z), bf_hi(w.z), s1); s2 = fmaf(bf_lo(w.w), bf_lo(w.w), s2); s3 = fmaf(bf_hi(w.w), bf_hi(w.w), s3); }
        float ss = (s0 + s1) + (s2 + s3); ss += __shfl_xor(ss, 16); ss += __shfl_xor(ss, 32);
        const float rs = 1.0f / sqrtf(ss * (1.f / 1024.f) + NORM_EPS);
        asm volatile("" ::: "memory");
        unsigned char* orow = H2 + ((size_t)tile * 16 + tok) * 1024 + 16 * g; const LAS float* gs = g2s + 16 * g;
#pragma unroll
        for (int kp = 0; kp < 16; ++kp) {
            v4u wa = __builtin_bit_cast(v4u, av[2 * kp]), wb = __builtin_bit_cast(v4u, av[2 * kp + 1]);
            asm volatile("" : "+v"(wa), "+v"(wb));
            const f32x4 ga = *(const LAS f32x4*)(gs + 64 * kp) * rs, gb = *(const LAS f32x4*)(gs + 64 * kp + 4) * rs, gc = *(const LAS f32x4*)(gs + 64 * kp + 8) * rs, gd = *(const LAS f32x4*)(gs + 64 * kp + 12) * rs;
            v4u o;
            o.x = pk4f8(bf_lo(wa.x) * ga.x, bf_hi(wa.x) * ga.y, bf_lo(wa.y) * ga.z, bf_hi(wa.y) * ga.w);
            o.y = pk4f8(bf_lo(wa.z) * gb.x, bf_hi(wa.z) * gb.y, bf_lo(wa.w) * gb.z, bf_hi(wa.w) * gb.w);
            o.z = pk4f8(bf_lo(wb.x) * gc.x, bf_hi(wb.x) * gc.y, bf_lo(wb.y) * gc.z, bf_hi(wb.y) * gc.w);
            o.w = pk4f8(bf_lo(wb.z) * gd.x, bf_hi(wb.z) * gd.y, bf_lo(wb.w) * gd.z, bf_hi(wb.w) * gd.w);
            *(v4u*)(orow + 64 * kp) = o;
            __builtin_amdgcn_sched_barrier(0);
        }
        __builtin_amdgcn_sched_barrier(0);
        const f32x4 d0 = acc[0] + acc[2], d1 = acc[1] + acc[3];
#pragma unroll
        for (int r = 0; r < 4; ++r) { const float rt = __shfl(rs, 4 * g + r); LG[(4 * g + r) * 33 + tok] = fmaf(d0[r], rt, b0); LG[(4 * g + r) * 33 + 16 + tok] = fmaf(d1[r], rt, b1); }
        __builtin_amdgcn_fence(__ATOMIC_RELEASE, "wavefront"); __builtin_amdgcn_wave_barrier(); __builtin_amdgcn_fence(__ATOMIC_ACQUIRE, "wavefront");
        float v0 = -INFINITY, v1 = -INFINITY, v2 = -INFINITY, v3 = -INFINITY; int e0 = 0, e1 = 0, e2 = 0, e3 = 0;
#pragma unroll
        for (int e = 0; e < 32; ++e) { const float x = LG[tok * 33 + e];
            const bool c0 = x > v0, c1 = x > v1, c2 = x > v2, c3 = x > v3;
            v3 = c2 ? v2 : (c3 ? x : v3); e3 = c2 ? e2 : (c3 ? e : e3);
            v2 = c1 ? v1 : (c2 ? x : v2); e2 = c1 ? e1 : (c2 ? e : e2);
            v1 = c0 ? v0 : (c1 ? x : v1); e1 = c0 ? e0 : (c1 ? e : e1);
            v0 = c0 ? x : v0;             e0 = c0 ? e : e0; }
        __builtin_amdgcn_wave_barrier();
        const float x1_ = __expf(v1 - v0), x2_ = __expf(v2 - v0), x3_ = __expf(v3 - v0); const float inv = 1.f / (1.f + x1_ + x2_ + x3_);
        const int row = tile * 16 + tok;
        if (g == 0) {
            *(int4*)(TOKE + (size_t)row * 4) = make_int4(e0, e1, e2, e3);
            *(f32x4*)(TOKW + (size_t)row * 4) = (f32x4){inv, x1_ * inv, x2_ * inv, x3_ * inv};
            if (rep_ == nrep - 1) { __hip_atomic_fetch_add(&hist[e0], 1u, __ATOMIC_RELAXED, __HIP_MEMORY_SCOPE_WORKGROUP); __hip_atomic_fetch_add(&hist[e1], 1u, __ATOMIC_RELAXED, __HIP_MEMORY_SCOPE_WORKGROUP);
                                    __hip_atomic_fetch_add(&hist[e2], 1u, __ATOMIC_RELAXED, __HIP_MEMORY_SCOPE_WORKGROUP); __hip_atomic_fetch_add(&hist[e3], 1u, __ATOMIC_RELAXED, __HIP_MEMORY_SCOPE_WORKGROUP); }
        }
    }
    __syncthreads();
    { int t_; asm volatile("v_mbcnt_lo_u32_b32 %0, -1, 0\n\tv_mbcnt_hi_u32_b32 %0, -1, %0" : "=v"(t_)); t_ += F.wave * 64;
      if (t_ < 32) { const unsigned base = __hip_atomic_fetch_add((unsigned*)(F.ctl + CW_CNT + t_), hist[t_], RLX_AGENT); ((int*)(F.ws + WS_WGB))[blockIdx.x * 32 + t_] = (int)base; } }
}

__device__ __forceinline__ void p8_scatter(Frame& F) {
    LAS int* seg = (LAS int*)F.lds;
    LAS int* lcnt = (LAS int*)(F.lds + 256);
    LAS int* wgb = (LAS int*)(F.lds + 512);
    int* tile_e = (int*)(F.ws + WS_TILEE);
    if (F.tid == 0) {
        int s = 0;
        for (int e = 0; e < 32; ++e) { seg[e] = s; const int c = (int)__hip_atomic_load((unsigned*)(F.ctl + CW_CNT + e), RLX_AGENT); s += (c + 255) & ~255; }
        seg[32] = s;
    }
    if (F.tid < 32) { lcnt[F.tid] = 0; wgb[F.tid] = ((const int*)(F.ws + WS_WGB))[blockIdx.x * 32 + F.tid]; }
    __syncthreads();
    if (blockIdx.x == 0) {
        for (int t = F.tid; t < MAX_TILES; t += 512) { int e = 0; for (int k = 1; k < 32; ++k) e += (seg[k] <= t * 256) ? 1 : 0; tile_e[t] = e; }
        if (F.tid == 0) tile_e[MAX_TILES] = seg[32] >> 8;
    }
    const int* TOKE = (const int*)(F.ws + WS_TOKE); const float* TOKW = (const float*)(F.ws + WS_TOKW); int* TOKS = (int*)(F.ws + WS_TOKS); float* SLOTW = (float*)(F.ws + WS_SLOTW);
    int* SLOTT = (int*)(F.ws + WS_SLOTT);
    const int lane = F.lane, gw = F.vcu * NWAVES + F.wave, NGW = F.G * NWAVES;
    for (int tile = gw; tile < T / 16; tile += NGW) {
        const int row = tile * 16 + (lane >> 2), k = lane & 3;
        const int e = TOKE[(size_t)row * 4 + k]; const int r = __hip_atomic_fetch_add(&lcnt[e], 1, __ATOMIC_RELAXED, __HIP_MEMORY_SCOPE_WORKGROUP);
        const int slot = seg[e] + wgb[e] + r; TOKS[(size_t)row * 4 + k] = slot; SLOTW[slot] = TOKW[(size_t)row * 4 + k]; SLOTT[slot] = row;
    }
}

__device__ __forceinline__ float f8_to_f32(unsigned w, int byte) { return byte == 0 ? __builtin_amdgcn_cvt_f32_fp8(w, 0) : byte == 1 ? __builtin_amdgcn_cvt_f32_fp8(w, 1) : byte == 2 ? __builtin_amdgcn_cvt_f32_fp8(w, 2) : __builtin_amdgcn_cvt_f32_fp8(w, 3); }
__device__ __forceinline__ void p11_final(Frame& F, const Args& a) {
    const float* gf = (const float*)a.in[18]; const bf16* X1 = (const bf16*)(F.ws + WS_X1); const unsigned char* Y8 = F.ws + WS_Y; const int* TOKS = (const int*)(F.ws + WS_TOKS);
    const int lane = F.lane, gw = F.vcu * NWAVES + F.wave, NGW = F.G * NWAVES;
    f32x4 gv[4];
#pragma unroll
    for (int j = 0; j < 4; ++j) gv[j] = *((const f32x4*)gf + lane + 64 * j);
    for (int row = gw; row < T; row += NGW) {
        const int4 sl = *(const int4*)(TOKS + (size_t)row * 4);
        const v2u* xr = (const v2u*)(X1 + (size_t)row * 1024) + lane; f32x4 v[4];
#pragma unroll
        for (int j = 0; j < 4; ++j) { const v2u w = xr[64 * j]; v[j] = (f32x4){bf_lo(w.x), bf_hi(w.x), bf_lo(w.y), bf_hi(w.y)}; }
        const int ss[4] = {sl.x, sl.y, sl.z, sl.w};
#pragma unroll
        for (int k = 0; k < 4; ++k) { const unsigned* yr = (const unsigned*)(Y8 + (size_t)ss[k] * 1024) + lane;
#pragma unroll
            for (int j = 0; j < 4; ++j) { const unsigned w = yr[64 * j];
                v[j].x += 0.0625f * f8_to_f32(w, 0); v[j].y += 0.0625f * f8_to_f32(w, 1); v[j].z += 0.0625f * f8_to_f32(w, 2); v[j].w += 0.0625f * f8_to_f32(w, 3); } }
        float s = 0.f;
#pragma unroll
        for (int j = 0; j < 4; ++j) s += (v[j].x * v[j].x + v[j].y * v[j].y) + (v[j].z * v[j].z + v[j].w * v[j].w);
        const float rs = 1.0f / sqrtf(wave_sum(s) * (1.f / 1024.f) + NORM_EPS);
        f32x4* o = (f32x4*)(a.out + (size_t)row * 1024) + lane;
#pragma unroll
        for (int j = 0; j < 4; ++j) __builtin_nontemporal_store(v[j] * rs * gv[j], o + 64 * j);
    }
}

constexpr int N_ITEMS_A = 640 + 768 + 256 + 128 + 128 + 128 + 1024, N_ITEMS_B = 1024;

__global__ void __launch_bounds__(NWAVES * 64, 2) hybrid_fwd(Args args) {
    extern __shared__ __attribute__((aligned(16))) unsigned char lds[];
    Frame F;
    F.lds = (LAS unsigned char*)lds;
    F.MISC = (volatile LAS unsigned*)(F.lds + MISC_OFF);
    F.tid = threadIdx.x; F.lane = F.tid & 63; F.wave = __builtin_amdgcn_readfirstlane(F.tid >> 6);
    F.G = gridDim.x; { const int bx = blockIdx.x; F.vcu = (F.G % 8 == 0) ? (bx % 8) * (F.G / 8) + bx / 8 : bx; }
    F.ws = args.ws; F.ctl = (gu32*)(args.ws + WS_CTL);
    for (int u = F.tid; u < (LDS_BYTES - LDSCTL_OFF) / 4; u += NWAVES * 64) ((LAS unsigned*)(F.lds + LDSCTL_OFF))[u] = 0u;
    __syncthreads();
    const int lo = args.ph_lo, hi = args.ph_hi;
    const bool multi = (hi - lo) > 1;
    XcdBarrier bar; bar.bar = (unsigned*)(F.ctl + CW_BAR); bar.x = 0; bar.st = nullptr;
    if (multi) bar = xcd_barrier_post((unsigned*)(F.ctl + CW_BAR), F.MISC + 8);
#ifndef PH_MASK
#define PH_MASK 0xfff
#endif
#define IN(k) (((PH_MASK >> (k)) & 1) && lo <= (k) && (k) < hi)
#ifndef REP_MASK
#define REP_MASK 0
#endif
#define NREPS(k) ((((REP_MASK) >> (k)) & 1) ? 1 + ((args.rep_mask >> (k)) & 1) : 1)
#define REP(k) _Pragma("unroll 1") for (int rep_ = 0; rep_ < ((((REP_MASK) >> (k)) & 1) ? 1 + ((args.rep_mask >> (k)) & 1) : 1); ++rep_)
#define FRESH() do { int t_ = threadIdx.x; asm volatile("" : "+v"(t_)); F.tid = t_; F.lane = t_ & 63; } while (0)
#ifdef DOUBLE_BAR
#define SEAM(k) do { if (IN(k) && IN((k) + 1)) { xcd_barrier(bar); xcd_barrier(bar); } } while (0)
#else
#define SEAM(k) do { if (IN(k) && IN((k) + 1)) xcd_barrier(bar); } while (0)
#endif
    unsigned char* ws = args.ws;
#define MAKE_AP() att::Ptrs AP; AP.ws = ws
    if (IN(0)) { FRESH(); REP(0) p0_prologue(F, args); SEAM(0); }
    if (IN(1)) { FRESH();
        pg8::Gemm g{(const bf16*)(ws + WS_H), (const bf16*)(ws + WS_WIN), 512, 512, 512, nullptr}; pg8::StaticOrder S; S.init(T, IN_PAD, F.G, (int)blockIdx.x, NREPS(1));
#ifdef EPI_TWICE
        g.epi2 = (EPI_TWICE == 1) ? ((args.rep_mask >> 16) & 1) : 0;
#endif
        epi::InProj E{(bf16*)(ws + WS_QC), (bf16*)(ws + WS_QR), (bf16*)(ws + WS_KV6), (bf16*)(ws + WS_F3), (bf16*)(ws + WS_G2), (float*)(ws + WS_SG), (const float*)(ws + WS_CS), (const float*)args.in[7]};
        pg8::gemm_phase<epi::InProj, pg8::StaticOrder, true, 0x7b7b7b7b>(F.lds + RING_OFF, g, S, E);
        SEAM(1);
    }
    if (IN(2)) { FRESH(); REP(2) p2_compress(F, args); SEAM(2); }
#ifdef STUB_ATTN
    if (IN(3)) { FRESH(); v4u* ao = (v4u*)(ws + WS_AO); for (size_t i = (size_t)blockIdx.x * 512 + F.tid; i < (size_t)T * 1024 / 8; i += (size_t)F.G * 512) ao[i] = (v4u){0u, 0u, 0u, 0u}; SEAM(3); }
    if (IN(4)) { FRESH(); SEAM(4); }
#else
#define ATTN_UNIT att::attn_unit2
    if (IN(3)) { FRESH();
        MAKE_AP();
        LAS int* qslot = (LAS int*)(F.lds + LDSCTL_OFF);
        const int nrep = 1 + ((args.rep_mask >> 3) & 1);
#ifdef CONV_INTERLEAVE
#define CONV_STEP() conv_one(F, args)
#else
#define CONV_STEP() do {} while (0)
#endif
#ifdef CONV_INTERLEAVE
#define CONV_DEDICATED 0
#else
#define CONV_DEDICATED (CONV_MOD != 0)
#endif
#define RUN_QUEUE(CW, NITEMS, ...) for (;;) { __syncthreads(); \
            if (F.tid == 0) qslot[0] = (int)__hip_atomic_fetch_add((unsigned*)(F.ctl + (CW)), 1u, RLX_AGENT); \
            __syncthreads(); int it = qslot[0]; if (it >= (NITEMS) * QREP(CW)) break; if (it >= (NITEMS)) it -= (NITEMS); __VA_ARGS__; }
#ifdef REPQ
#define QREP(CW) ((CW) == (REPQ) ? nrep : 1)
#else
#define QREP(CW) nrep
#endif
        if (CONV_DEDICATED && (int)blockIdx.x % (CONV_MOD ? CONV_MOD : 1) == 0) conv_drain(F, args, CW_Q3, 1024);
#ifndef SKIPQ0
        RUN_QUEUE(CW_Q0, 512, { const int qb = 7 - it / 64, r_ = it % 64; ATTN_UNIT<0>(r_ >> 2, r_ & 3, qb, AP, (LAS char*)F.lds); CONV_STEP(); });
#endif
#ifndef SKIPQ2
        RUN_QUEUE(CW_Q2, 512, { const int qb = 7 - it / 64, r_ = it % 64; ATTN_UNIT<1>(r_ >> 2, r_ & 3, qb, AP, (LAS char*)F.lds); CONV_STEP(); });
#endif
#ifndef SKIPQ3
        RUN_QUEUE(CW_Q3, 1024, { att::cmp_unit(it >> 6, (it >> 5) & 1, it & 31, AP, (LAS char*)F.lds); CONV_STEP(); });
#endif
        SEAM(3);
    }
#ifdef P4_COPY
    if (IN(4)) { FRESH(); const v4u* srcp = (const v4u*)(ws + (P4_COPY == 1 ? WS_OW : WS_OC)); for (size_t i = (size_t)blockIdx.x * 512 + F.tid; i < (size_t)T * 64; i += (size_t)F.G * 512) { const size_t r = i >> 6, c = i & 63; ((v4u*)(ws + WS_AO))[r * 128 + c] = srcp[i]; } SEAM(4); }
    if (0) {
#elif defined(ONLY_FOX)
    if (IN(4)) { FRESH(); for (size_t i = (size_t)blockIdx.x * 512 + F.tid; i < (size_t)T * 64; i += (size_t)F.G * 512) { const size_t r = i >> 6, c = i & 63; ((v4u*)(ws + WS_AO))[r * 128 + c] = (v4u){0u, 0u, 0u, 0u}; } SEAM(4); }
    if (0) {
#else
    if (IN(4)) { FRESH();
#endif
        MAKE_AP();
        LAS int* qslot = (LAS int*)(F.lds + LDSCTL_OFF);
        const int nrep = 1 + ((args.rep_mask >> 4) & 1);
        if (CONV_DEDICATED && (int)blockIdx.x % (CONV_MOD ? CONV_MOD : 1) == 0) conv_drain(F, args, CW_Q1, 512);
        RUN_QUEUE(CW_Q1, 512, { const int qb = 7 - it / 64, r_ = it % 64; ATTN_UNIT<2>(r_ >> 2, r_ & 3, qb, AP, (LAS char*)F.lds); CONV_STEP(); CONV_STEP(); });
        if (CONV_MOD != 0) conv_drain(F, args, -1, 0);
        SEAM(4);
    }
#endif
    if (IN(5)) { FRESH();
        pg8::StaticOrder S; S.init(T, 1024, F.G, (int)blockIdx.x, NREPS(5));
        { pg8::Gemm g{(const bf16*)(ws + WS_AO), (const bf16*)(ws + WS_WP), 1024, 1024, 1024, nullptr};
#ifdef EPI_TWICE
        g.epi2 = (EPI_TWICE == 5) ? ((args.rep_mask >> 16) & 1) : 0;
#endif
          epi::GateMix E{(const bf16*)(ws + WS_G2), (const bf16*)(ws + WS_G2) + (size_t)T * 1024, (bf16*)(ws + WS_MX)};
          pg8::gemm_phase<epi::GateMix, pg8::StaticOrder, true>(F.lds + RING_OFF, g, S, E); }
        SEAM(5);
    }
    if (IN(6)) { FRESH();
        pg8::Gemm g{(const bf16*)(ws + WS_MX), (const bf16*)(ws + WS_WOUT), 1024, 1024, 1024, nullptr}; pg8::StaticOrder S; S.init(T, 1024, F.G, (int)blockIdx.x, NREPS(6));
#ifdef EPI_TWICE
        g.epi2 = (EPI_TWICE == 6) ? ((args.rep_mask >> 16) & 1) : 0;
#endif
        epi::ResOut E{(const float*)args.in[0], (bf16*)(ws + WS_X1)};
        pg8::gemm_phase<epi::ResOut, pg8::StaticOrder, true>(F.lds + RING_OFF, g, S, E);
        SEAM(6);
    }
    if (IN(7)) { FRESH(); p7_route(F, args, NREPS(7)); SEAM(7); }
    if (IN(8)) { FRESH(); p8_scatter(F); SEAM(8); }
    if (IN(9)) { FRESH();
        const int* tile_e = (const int*)(ws + WS_TILEE); const int nMt = __builtin_amdgcn_readfirstlane(tile_e[MAX_TILES]);
        pg8::Gemm g{(const bf16*)(ws + WS_H2), (const bf16*)(ws + WS_W1), 512, 512, 512, (const int*)(ws + WS_SLOTT)};
#ifdef EPI_TWICE
        g.epi2 = (EPI_TWICE == 9) ? ((args.rep_mask >> 16) & 1) : 0;
#endif
        LAS int* te_l = (LAS int*)(F.lds + 131072); for (int i = F.tid; i < MAX_TILES; i += 512) te_l[i] = tile_e[i]; __syncthreads();
        pg8::MoeOrder S; S.init(nMt, 8, F.G, (int)blockIdx.x, te_l, NREPS(9));
        epi::Moe1 E{(const float*)args.in[15], ws + WS_ACT};
        pg8::gemm_phase<epi::Moe1, pg8::MoeOrder, MOE_ALIGN, 0x7b7b7b7b, true>(F.lds + RING_OFF, g, S, E);
        SEAM(9);
    }
    if (IN(10)) { FRESH();
        const int* tile_e = (const int*)(ws + WS_TILEE); const int nMt = __builtin_amdgcn_readfirstlane(tile_e[MAX_TILES]);
        pg8::Gemm g{(const bf16*)(ws + WS_ACT), (const bf16*)(ws + WS_W2), 512, 512, 512, nullptr}; LAS int* te_l = (LAS int*)(F.lds + 131072); for (int i = F.tid; i < MAX_TILES; i += 512) te_l[i] = tile_e[i]; __syncthreads();
#ifdef EPI_TWICE
        g.epi2 = (EPI_TWICE == 10) ? ((args.rep_mask >> 16) & 1) : 0;
#endif
        pg8::MoeOrder S; S.init(nMt, 4, F.G, (int)blockIdx.x, te_l, NREPS(10));
        epi::Moe2 E{(const float*)args.in[17], (const float*)(ws + WS_SLOTW), ws + WS_Y};
        pg8::gemm_phase<epi::Moe2, pg8::MoeOrder, MOE_ALIGN, 0x7d7d7d7d>(F.lds + RING_OFF, g, S, E);
        SEAM(10);
    }
    if (IN(11)) { FRESH(); REP(11) p11_final(F, args); }
#undef IN
#undef SEAM
}

#ifndef MK_PER_PHASE
#define MK_PER_PHASE 0
#endif
extern "C" void kernel_launch(void* const* d_in, const int* in_sizes, int n_in, void* d_out, int out_size, void* d_ws, size_t ws_size, hipStream_t stream) {
    static int grid = 0;
    if (grid == 0) {
        if (n_in != 19 || out_size != T * D_MODEL || ws_size < WS_END) { fprintf(stderr, "kernel_launch: unexpected shapes (n_in %d, out %d, ws %zu)\n", n_in, out_size, ws_size); grid = -1; return; }
        int dev = 0, cus = 0, per_cu = 0;
        if (hipGetDevice(&dev) != hipSuccess || hipDeviceGetAttribute(&cus, hipDeviceAttributeMultiprocessorCount, dev) != hipSuccess) { grid = -1; return; }
        if (hipFuncSetAttribute((const void*)hybrid_fwd, hipFuncAttributeMaxDynamicSharedMemorySize, LDS_BYTES) != hipSuccess) { fprintf(stderr, "kernel_launch: hipFuncSetAttribute failed\n"); grid = -1; return; }
        if (hipOccupancyMaxActiveBlocksPerMultiprocessor(&per_cu, (const void*)hybrid_fwd, NWAVES * 64, LDS_BYTES) != hipSuccess || per_cu < 1) { fprintf(stderr, "kernel_launch: occupancy query reports %d\n", per_cu); }
        (void)hipGetLastError();
        grid = cus;
    }
    if (grid < 0) return;
    (void)hipMemsetAsync((char*)d_ws + WS_CTL, 0, CTL_ZERO_BYTES, stream);
    Args a{};
    for (int i = 0; i < 19; ++i) a.in[i] = d_in[i];
    a.out = (float*)d_out; a.ws = (unsigned char*)d_ws; a.rep_mask = REP_MASK;
#if MK_PER_PHASE
    for (int p = 0; p < 12; ++p) { a.ph_lo = p; a.ph_hi = p + 1; hipLaunchKernelGGL(hybrid_fwd, dim3(grid), dim3(NWAVES * 64), LDS_BYTES, stream, a); }
#else
    a.ph_lo = 0; a.ph_hi = 12;
    hipLaunchKernelGGL(hybrid_fwd, dim3(grid), dim3(NWAVES * 64), LDS_BYTES, stream, a);
#endif
}
```
